# Optimizing an MI355X kernel written in HIP

```python
import math
import jax, jax.numpy as jnp
from jax import lax
import numpy as np

D_MODEL = 1024
BATCH = 8
SEQ = 4096
DEPTH = 2

HG_HEADS = 4
HG_DK = 128
HG_DV = 128
HG_WIDTH = HG_HEADS * HG_DV
HG_CHUNK = 64
DA_HEADS = 4
DA_HEAD_DIM = 64
DA_V_DIM = 2 * DA_HEAD_DIM
DA_WIDTH = DA_HEADS * DA_V_DIM
Q_BLOCK = 128
D_FF = 2816
N_EXPERTS = 8
TOP_K = 2
D_FF_EXPERT = 3584
N_DENSE = (DEPTH + 1) // 2
N_MOE = DEPTH // 2
ADA_CHUNKS = 6
EPS = 1e-6
IN_SIZES = (HG_HEADS * HG_DK, HG_HEADS * HG_DK, HG_WIDTH, HG_WIDTH,
            DA_HEADS * 2 * DA_HEAD_DIM, DA_HEADS * 2 * DA_HEAD_DIM, DA_WIDTH,
            D_MODEL, D_MODEL)
D_IN = sum(IN_SIZES)

kernel_name = "hybrid_hgrn2_diffattn_moe_adaln"


def rmsnorm(x, g):
    xf = x.astype(jnp.float32)
    y = xf * lax.rsqrt(jnp.mean(xf * xf, axis=-1, keepdims=True) + EPS)
    return y * g.astype(jnp.float32)


def split_points():
    return [int(v) for v in np.cumsum(np.array(IN_SIZES))[:-1]]


def alibi_slopes(n_heads):
    return jnp.asarray(2.0 ** (-8.0 * np.arange(1, n_heads + 1) / n_heads), dtype=jnp.float32)


def hgrn_lower_bounds(lb_logits):
    p = jax.nn.softmax(lb_logits.astype(jnp.float32), axis=0)
    cum = jnp.cumsum(p, axis=0)
    return cum - cum[0:1]


def hgrn2_chunk_scan(q, k, v, log_f):
    B, H, S, dk = q.shape
    dv = v.shape[-1]
    L = HG_CHUNK
    nc = S // L

    def to_chunks(t):
        return jnp.moveaxis(t.reshape(B, H, nc, L, t.shape[-1]), 2, 0)

    causal = jnp.tril(jnp.ones((L, L), dtype=bool))

    def step(state, inp):
        qb, kb, vb, gb = inp
        b = jnp.cumsum(gb, axis=2)
        o_inter = jnp.einsum('bhtk,bhkv->bhtv', qb * jnp.exp(b), state)
        rel = b[:, :, :, None, :] - b[:, :, None, :, :]
        decay = jnp.exp(jnp.where(causal[:, :, None], rel, -jnp.inf))
        scores = jnp.einsum('bhtk,bhsk,bhtsk->bhts', qb, kb, decay)
        o_intra = jnp.einsum('bhts,bhsv->bhtv', scores, vb)
        b_last = b[:, :, -1:, :]
        k_dec = kb * jnp.exp(b_last - b)
        new_state = jnp.exp(b_last[:, :, 0, :])[..., None] * state + jnp.einsum('bhsk,bhsv->bhkv', k_dec, vb)
        return new_state, o_inter + o_intra

    s0 = jnp.zeros((B, H, dk, dv), jnp.float32)
    _, o = lax.scan(step, s0, (to_chunks(q), to_chunks(k), to_chunks(v), to_chunks(log_f)))
    return jnp.moveaxis(o, 0, 2).reshape(B, H, S, dv)


def diff_attention(q, k, v, lam):
    B, H, _, S, d = q.shape
    dv = v.shape[-1]
    nb = S // Q_BLOCK
    scale = d ** -0.5
    slopes = alibi_slopes(H)
    kpos = jnp.arange(S)
    q_blocks = jnp.moveaxis(q.reshape(B, H, 2, nb, Q_BLOCK, d), 3, 0)

    def block(args):
        qb, bi = args
        qpos = bi * Q_BLOCK + jnp.arange(Q_BLOCK)
        dist = qpos[:, None] - kpos[None, :]
        s = jnp.einsum('bhcqd,bhcsd->bhcqs', qb, k) * scale
        s = s - slopes[None, :, None, None, None] * dist.astype(jnp.float32)
        s = jnp.where(dist >= 0, s, -jnp.inf)
        p = jax.nn.softmax(s, axis=-1)
        w = p[:, :, 0] - lam * p[:, :, 1]
        return jnp.einsum('bhqs,bhsv->bhqv', w, v)

    o = lax.map(block, (q_blocks, jnp.arange(nb)))
    return jnp.moveaxis(o, 0, 2).reshape(B, H, S, dv)


def token_mixer(h, layer, w_in, lb, hg_norm_g, qn_g, kn_g, lam_vecs, subln_g, w_pa, w_pb, w_o):
    B, S, _ = h.shape
    dt = h.dtype
    proj = h @ w_in
    hq, hf, hi, hg, dq, dk, dvv, ga, gb = jnp.split(proj, split_points(), axis=-1)

    def heads(t, d):
        return t.reshape(B, S, -1, d).transpose(0, 2, 1, 3).astype(jnp.float32)
    z = heads(hf, HG_DK)
    lbh = lb.reshape(HG_HEADS, 1, HG_DK)
    log_f = jnp.logaddexp(jnp.log(lbh), jnp.log1p(-lbh) + jax.nn.log_sigmoid(z))
    k_in = (1.0 - lbh) * jax.nn.sigmoid(-z)
    o_hg = hgrn2_chunk_scan(heads(hq, HG_DK), k_in, heads(hi, HG_DV), log_f)
    o_hg = rmsnorm(o_hg, hg_norm_g).transpose(0, 2, 1, 3).reshape(B, S, HG_WIDTH)
    o_hg = (o_hg * jax.nn.silu(hg.astype(jnp.float32))).astype(dt)

    q = dq.reshape(B, S, DA_HEADS, 2, DA_HEAD_DIM).transpose(0, 2, 3, 1, 4)
    k = dk.reshape(B, S, DA_HEADS, 2, DA_HEAD_DIM).transpose(0, 2, 3, 1, 4)
    v = dvv.reshape(B, S, DA_HEADS, DA_V_DIM).transpose(0, 2, 1, 3).astype(jnp.float32)
    q = rmsnorm(q, qn_g)
    k = rmsnorm(k, kn_g)
    lam_init = 0.8 - 0.6 * math.exp(-0.3 * layer)
    lv = lam_vecs.astype(jnp.float32)
    lam = jnp.exp(jnp.sum(lv[0] * lv[1])) - jnp.exp(jnp.sum(lv[2] * lv[3])) + lam_init
    o_da = diff_attention(q, k, v, lam)
    o_da = (rmsnorm(o_da, subln_g) * (1.0 - lam_init)).transpose(0, 2, 1, 3).reshape(B, S, DA_WIDTH).astype(dt)

    y = jax.nn.sigmoid(ga) * (o_hg @ w_pa) + jax.nn.sigmoid(gb) * (o_da @ w_pb)
    return y @ w_o


def swiglu(h, w1, w3, w2):
    return (jax.nn.silu(h @ w1) * (h @ w3)) @ w2


def moe_swiglu(h, router, w1, w3, w2):
    B, S, D = h.shape
    t = h.reshape(B * S, D)
    logits = (t @ router).astype(jnp.float32)
    vals, idx = lax.top_k(logits, TOP_K)
    wts = jax.nn.softmax(vals, axis=-1)
    comb = jnp.sum(jax.nn.one_hot(idx, N_EXPERTS, dtype=jnp.float32) * wts[..., None], axis=1)
    out = jnp.zeros_like(t)
    for e in range(N_EXPERTS):
        out = out + comb[:, e:e + 1].astype(t.dtype) * swiglu(t, w1[e], w3[e], w2[e])
    return out.reshape(B, S, D)


def setup_inputs(seed: int = 0) -> dict:
    key = jax.random.key(seed)
    ks = jax.random.split(key, 24)
    f32 = jnp.float32
    D = D_MODEL

    def nrm(k, shape, scale):
        return jax.random.normal(k, shape, f32) * scale

    def gain(k, shape):
        return 1.0 + 0.05 * jax.random.normal(k, shape, f32)

    return {
        "x": nrm(ks[0], (BATCH, SEQ, D), 1.0),
        "c": nrm(ks[1], (BATCH, D), 1.0),
        "ada_w": nrm(ks[2], (DEPTH, D, ADA_CHUNKS * D), 0.5 * D ** -0.5),
        "ada_b": nrm(ks[3], (DEPTH, ADA_CHUNKS * D), 0.02),
        "norm_mix_g": gain(ks[4], (DEPTH, D)),
        "norm_ffn_g": gain(ks[5], (DEPTH, D)),
        "w_in": nrm(ks[6], (DEPTH, D, D_IN), D ** -0.5),
        "hgrn_lb_logits": nrm(ks[7], (DEPTH, HG_HEADS * HG_DK), 0.5),
        "hgrn_norm_g": gain(ks[8], (DEPTH, HG_DV)),
        "da_qnorm_g": gain(ks[9], (DEPTH, DA_HEAD_DIM)),
        "da_knorm_g": gain(ks[10], (DEPTH, DA_HEAD_DIM)),
        "da_lambda": nrm(ks[11], (DEPTH, 4, DA_HEAD_DIM), 0.1),
        "da_subln_g": gain(ks[12], (DEPTH, DA_V_DIM)),
        "w_branch_a": nrm(ks[13], (DEPTH, HG_WIDTH, D), HG_WIDTH ** -0.5),
        "w_branch_b": nrm(ks[14], (DEPTH, DA_WIDTH, D), DA_WIDTH ** -0.5),
        "w_out": nrm(ks[15], (DEPTH, D, D), D ** -0.5),
        "ffn_w1": nrm(ks[16], (N_DENSE, D, D_FF), D ** -0.5),
        "ffn_w3": nrm(ks[17], (N_DENSE, D, D_FF), D ** -0.5),
        "ffn_w2": nrm(ks[18], (N_DENSE, D_FF, D), D_FF ** -0.5),
        "moe_router": nrm(ks[19], (N_MOE, D, N_EXPERTS), D ** -0.5),
        "moe_w1": nrm(ks[20], (N_MOE, N_EXPERTS, D, D_FF_EXPERT), D ** -0.5),
        "moe_w3": nrm(ks[21], (N_MOE, N_EXPERTS, D, D_FF_EXPERT), D ** -0.5),
        "moe_w2": nrm(ks[22], (N_MOE, N_EXPERTS, D_FF_EXPERT, D), D_FF_EXPERT ** -0.5),
    }


def reference(x, c, ada_w, ada_b, norm_mix_g, norm_ffn_g, w_in, hgrn_lb_logits, hgrn_norm_g,
              da_qnorm_g, da_knorm_g, da_lambda, da_subln_g, w_branch_a, w_branch_b, w_out,
              ffn_w1, ffn_w3, ffn_w2, moe_router, moe_w1, moe_w3, moe_w2):
    dt = x.dtype
    lb_all = hgrn_lower_bounds(hgrn_lb_logits)
    cs = jax.nn.silu(c)
    for l in range(DEPTH):
        ada = cs @ ada_w[l] + ada_b[l]
        sh1, sc1, g1, sh2, sc2, g2 = jnp.split(ada[:, None, :], ADA_CHUNKS, axis=-1)
        h = (rmsnorm(x, norm_mix_g[l]) * (1.0 + sc1) + sh1).astype(dt)
        x = x + g1 * token_mixer(h, l, w_in[l], lb_all[l], hgrn_norm_g[l], da_qnorm_g[l], da_knorm_g[l],
                                 da_lambda[l], da_subln_g[l], w_branch_a[l], w_branch_b[l], w_out[l])
        h = (rmsnorm(x, norm_ffn_g[l]) * (1.0 + sc2) + sh2).astype(dt)
        if l % 2 == 0:
            f = swiglu(h, ffn_w1[l // 2], ffn_w3[l // 2], ffn_w2[l // 2])
        else:
            f = moe_swiglu(h, moe_router[l // 2], moe_w1[l // 2], moe_w3[l // 2], moe_w2[l // 2])
        x = x + g2 * f
    return x
```

```cpp
#include <hip/hip_runtime.h>
#include <cstdio>
#include <cstdint>

#define GAS __attribute__((address_space(1)))
#define LAS __attribute__((address_space(3)))
typedef unsigned short bf16;
typedef short bf16x8 __attribute__((ext_vector_type(8)));
typedef float f32x4 __attribute__((ext_vector_type(4)));
typedef float f32x2 __attribute__((ext_vector_type(2)));
typedef unsigned u32x4 __attribute__((ext_vector_type(4)));
typedef unsigned u32x2 __attribute__((ext_vector_type(2)));
typedef GAS unsigned gu32;

constexpr int NB = 8, SEQ = 4096, D = 1024, M = NB * SEQ, DEPTH = 2;
constexpr int DIN = 5632;
constexpr int C_HQ = 0, C_HF = 512, C_HI = 1024, C_HG = 1536, C_DQ = 2048, C_DK = 2560, C_DV = 3072, C_GA = 3584, C_GB = 4608;
constexpr int DFF = 2816, NEXP = 8, DFFE = 3584;
constexpr int ADA_N = 6 * D;
constexpr float EPS = 1e-6f;
constexpr float LOG2E = 1.4426950408889634f;
constexpr int NWAVES = 8, NTHR = 512;
constexpr int MOE_ROWS = 34816;

constexpr size_t MiB = 1u << 20;
constexpr size_t WS_CTL = 0, CTL_ZERO_BYTES = 1 * MiB;
constexpr size_t WS_ADA = 1 * MiB;
constexpr size_t WS_WIN8 = 2 * MiB;
constexpr size_t WS_WPAB = 13 * MiB;
constexpr size_t WS_WO = 17 * MiB;
constexpr size_t WS_W13 = 21 * MiB;
constexpr size_t WS_W2 = 26 * MiB + 512 * 1024;
constexpr size_t WS_H = 50 * MiB;
constexpr size_t WS_KIMG = 50 * MiB;
constexpr size_t WS_VIMG = 82 * MiB;
constexpr size_t WS_H8 = 114 * MiB;
constexpr size_t WS_OCAT = 114 * MiB;
constexpr size_t WS_PROJ = 178 * MiB;
constexpr size_t WS_HID = 178 * MiB;
constexpr size_t WS_MW13 = 178 * MiB;
constexpr size_t WS_MW2 = 234 * MiB;
constexpr size_t WS_HIDM = 262 * MiB;
constexpr size_t WS_HL = 32 * MiB;
constexpr size_t WS_HD = 48 * MiB;
constexpr size_t WS_X16 = 530 * MiB;
constexpr size_t WS_END = 594 * MiB;
constexpr size_t WS_TOKE = WS_OCAT;
constexpr size_t WS_TOKW = WS_OCAT + 1 * MiB;
constexpr size_t WS_LIST = WS_OCAT + 2 * MiB;
constexpr size_t WS_WL = WS_OCAT + 3 * MiB;
constexpr size_t WS_RSL = WS_OCAT + 4 * MiB;
constexpr int AO_ADA = 0, AO_LB = 2 * NB * ADA_N, AO_MISC = AO_LB + 2 * 512, AO_ORD = AO_MISC + 16, AO_RS = AO_ORD + 2048;
constexpr int CW_TMO = 0, CW_CODE = 1, CW_BAR = 4096, CW_MOE = 8192, CW_ATT = 12288;

constexpr int RING_BYTES = 131072, LDSCTL_OFF = RING_BYTES, MISC_OFF = LDSCTL_OFF + 320, LDS_BYTES = 147456;
constexpr int LC_CNT = 0, LC_TOFF = 16, LC_TOT = 32, LC_LH = 40, LC_BASE = 56;

#define RLX_AGENT __ATOMIC_RELAXED, __HIP_MEMORY_SCOPE_AGENT
#define LDS_WAIT() asm volatile("s_waitcnt lgkmcnt(0)" ::: "memory")
#define VM_WAIT() asm volatile("s_waitcnt vmcnt(0)" ::: "memory")

__device__ __forceinline__ unsigned f2bf(float f) { unsigned u = __builtin_bit_cast(unsigned, f); return (u + 0x7fffu + ((u >> 16) & 1u)) >> 16; }
__device__ __forceinline__ unsigned pk2(float lo, float hi) { unsigned r; asm("v_cvt_pk_bf16_f32 %0, %1, %2" : "=v"(r) : "v"(lo), "v"(hi)); return r; }
__device__ __forceinline__ float bflo(unsigned w) { return __uint_as_float(w << 16); }
__device__ __forceinline__ float bfhi(unsigned w) { return __uint_as_float(w & 0xffff0000u); }
__device__ __forceinline__ float bf2f(bf16 v) { return __uint_as_float((unsigned)v << 16); }
__device__ __forceinline__ unsigned pk4_fp8(float a, float b, float c, float d) { unsigned w = 0; w = __builtin_amdgcn_cvt_pk_fp8_f32(a, b, w, false); w = __builtin_amdgcn_cvt_pk_fp8_f32(c, d, w, true); return w; }
constexpr float QW_SCALE = 720.f, QW_INV = 1.f / QW_SCALE;
__device__ __forceinline__ unsigned q8(float x) { return (unsigned)(int)rintf(fminf(fmaxf(x, -127.f), 127.f)) & 0xffu; }
__device__ __forceinline__ unsigned pk4_i8(float a, float b, float c, float d) { return q8(a) | (q8(b) << 8) | (q8(c) << 16) | (q8(d) << 24); }
constexpr float W8_SCALE = 64.f, W8_INV = 1.f / 64.f;
__device__ __forceinline__ float sigm(float x) { return __builtin_amdgcn_rcpf(1.f + __builtin_amdgcn_exp2f(-LOG2E * x)); }
__device__ __forceinline__ unsigned lds_inc(volatile LAS unsigned* p) { return __hip_atomic_fetch_add((LAS unsigned*)p, 1u, __ATOMIC_RELAXED, __HIP_MEMORY_SCOPE_WORKGROUP); }
__device__ __forceinline__ float wave_sum(float v) {
#pragma unroll
    for (int o = 1; o < 64; o <<= 1) v += __shfl_xor(v, o);
    return v;
}

namespace pg8 {
constexpr int BM = 256, BK = 64, HALF = 128, HTB = HALF * BK * 2, STAGE_BYTES = 8 * HTB, NXCD = 8, WGM = 8;
__host__ __device__ __forceinline__ int lds_byte(int r, int c) { const int st = (r >> 4) * 2 + (c >> 5), rr = r & 15, cc = c & 31, ob = rr * 64 + cc * 2; return st * 1024 + (ob ^ (((ob >> 9) & 1) << 5)); }
__host__ __device__ __forceinline__ void stage_rc(int b, int& R, int& C) { const int st = b / 1024, sb = b % 1024, swz = sb ^ (((sb >> 9) & 1) << 5); R = (st >> 1) * 16 + swz / 64; C = (st & 1) * 32 + (swz % 64) / 2; }
__host__ __device__ __forceinline__ int perm32(int rho) { const int n = rho >> 4, i = rho & 15; return 8 * (i >> 2) + 4 * n + (i & 3); }

struct Unit { int pm, pn, e, nvalid; };
struct Gemm { const bf16* A; const bf16* Bt; int K; };

struct StaticOrder {
    int nM, nN, nwg, G, c, rm0, rm1;
    __device__ void init(int M_, int N_, int G_, int c_, int rm0_ = 0, int rm1_ = 0) { nM = M_ / BM; nN = N_ / BM; nwg = nM * nN; G = G_; c = c_; rm0 = rm0_; rm1 = rm1_; }
    __device__ bool next(int i, Unit& u) const {
        const long L = (long)i * G + c; if (L >= nwg) return false;
        int wgid = (int)L; { const int q = nwg / NXCD, r = nwg % NXCD, xcd = wgid % NXCD, off = wgid / NXCD; wgid = (xcd < r ? xcd * (q + 1) : r * (q + 1) + (xcd - r) * q) + off; }
        const int nig = WGM * nN, gid = wgid / nig, fm = gid * WGM, gsz = (nM - fm) < WGM ? (nM - fm) : WGM;
        const int wi = wgid % nig; if (gsz == WGM) { u.pm = fm + (wi & (WGM - 1)); u.pn = wi / WGM; } else { u.pm = fm + (wi % gsz); u.pn = wi / gsz; }
        u.pn += u.pn < 4 ? rm0 : rm1; u.e = 0; u.nvalid = 256; return true;
    }
};
struct MoeOrder {
    const volatile LAS unsigned* lc; int s, nN, G, c; int hv = 0, skipr = 0;
    __device__ bool next(int i, Unit& u) const {
        const int T0 = (int)lc[LC_TOT], T1 = (int)lc[LC_TOT + 1], T = s == 2 ? T0 + T1 : (s == 0 ? T0 : T1);
        const int nwg = __builtin_amdgcn_readfirstlane(T * nN); long L;
        if (c < hv) { L = (long)(i + skipr) * G + c; if (L >= (long)nwg) return false; }
        else { L = (long)i * G + c;
            if (L >= (long)nwg) { if (hv == 0) return false;
                const int nreg = c < nwg ? (nwg - c + G - 1) / G : 0, m = (c - hv) + (i - nreg) * (G - hv); if (m >= skipr * hv) return false;
                L = (long)(m / hv) * G + (m % hv); } }
        int wgid = (int)L; { const int q = nwg / NXCD, r = nwg % NXCD, xcd = wgid % NXCD, off = wgid / NXCD; wgid = (xcd < r ? xcd * (q + 1) : r * (q + 1) + (xcd - r) * q) + off; }
        const int nig = WGM * nN, gid = wgid / nig, fm = gid * WGM, gsz = (T - fm) < WGM ? (T - fm) : WGM;
        const int wi = wgid % nig; int rt, pnl; if (gsz == WGM) { rt = fm + (wi & (WGM - 1)); pnl = wi / WGM; } else { rt = fm + (wi % gsz); pnl = wi / gsz; } int sl = s;
        if (s == 2) { sl = rt >= T0 ? 1 : 0; rt -= sl * T0; }
        int e = 0;
#pragma unroll
        for (int k = 1; k < NEXP; ++k) if ((int)lc[LC_TOFF + sl * 8 + k] <= rt) e = k;
        const int left = (int)lc[LC_CNT + sl * 8 + e] - (rt - (int)lc[LC_TOFF + sl * 8 + e]) * 256;
        u.pm = __builtin_amdgcn_readfirstlane(sl * (MOE_ROWS / 256) + rt); u.pn = __builtin_amdgcn_readfirstlane(e * nN + pnl); u.e = __builtin_amdgcn_readfirstlane(e);
        u.nvalid = __builtin_amdgcn_readfirstlane(left < 256 ? left : 256); return true;
    }
};
struct ADense { static constexpr bool GATHER = false; __device__ __forceinline__ void get(const Unit&, int, int, unsigned (&)[2][2]) const {}
    __device__ __forceinline__ void rows(const Unit&, int, int (&)[2][2]) const {} __device__ __forceinline__ void offs(const int (&)[2][2], int, int, unsigned (&)[2][2]) const {} };
struct AGather { static constexpr bool GATHER = true; const int* list;
    __device__ __forceinline__ void rows(const Unit& u, int tid, int (&row)[2][2]) const {
#pragma unroll
        for (int i = 0; i < 2; ++i) { int R, C; stage_rc(tid * 16 + i * 8192, R, C);
#pragma unroll
            for (int h = 0; h < 2; ++h) row[h][i] = list[u.pm * BM + h * HALF + R]; } }
    __device__ __forceinline__ void offs(const int (&row)[2][2], int tid, int K, unsigned (&off)[2][2]) const {
#pragma unroll
        for (int i = 0; i < 2; ++i) { int R, C; stage_rc(tid * 16 + i * 8192, R, C);
#pragma unroll
            for (int h = 0; h < 2; ++h) off[h][i] = (unsigned)((row[h][i] * K + C) * 2); } }
    __device__ __forceinline__ void get(const Unit& u, int tid, int K, unsigned (&off)[2][2]) const { int row[2][2]; rows(u, tid, row); offs(row, tid, K, off); } };

__device__ __forceinline__ unsigned cvt_pk_bf16(float lo, float hi) { unsigned r; asm volatile("v_cvt_pk_bf16_f32 %0, %1, %2" : "=v"(r) : "v"(lo), "v"(hi)); return r; }

typedef f32x4 Acc[2][2][4][2];
typedef int v8i __attribute__((ext_vector_type(8)));
typedef int v4i __attribute__((ext_vector_type(4)));
__device__ __forceinline__ f32x4 acc_i2f(f32x4 v) { const v4i i = __builtin_bit_cast(v4i, v); return (f32x4){(float)i.x, (float)i.y, (float)i.z, (float)i.w}; }
typedef short bf16x16 __attribute__((ext_vector_type(16)));

constexpr int IMAGIC = 0x4B400000; constexpr float FMAGIC = 12582912.f;
template <bool AI = false> struct EpiBf16 {
    static constexpr bool PERM = true; static constexpr int MID_T = 0; static constexpr bool HAS_PRE = true; static constexpr bool MAGIC = AI;
    bf16* O; int ldc; float asc; const float* rs; int sig_from = 1 << 30;
    __device__ __forceinline__ void mid(Acc&, const Unit&, int, int, int, int) const {}
    __device__ __forceinline__ void prefetch(const Unit& u, int wr, int fr, float (&p)[8]) const {
        if (rs) {
#pragma unroll
            for (int i = 0; i < 8; ++i) p[i] = rs[u.pm * BM + wr * 64 + fr + (i >> 2) * HALF + (i & 3) * 16]; } }
    __device__ __forceinline__ void operator()(const Acc& acc, const Unit& u, int wr, int wc, int fr, int fq, const float* pre = nullptr) const {
        const int row0 = u.pm * BM + wr * 64 + fr, col0 = u.pn * BM + wc * 32 + 8 * fq;
#pragma unroll
        for (int ai = 0; ai < 2; ++ai)
#pragma unroll
            for (int m = 0; m < 4; ++m) { bf16* rowp = O + (size_t)(row0 + ai * HALF + m * 16) * ldc + col0; const float sc = rs ? asc * (pre ? pre[ai * 4 + m] : rs[row0 + ai * HALF + m * 16]) : asc; const float nb = AI ? -FMAGIC * sc : 0.f;
#pragma unroll
                for (int bj = 0; bj < 2; ++bj) { const f32x4 v0 = AI ? __builtin_elementwise_fma(acc[ai][bj][m][0], (f32x4){sc, sc, sc, sc}, (f32x4){nb, nb, nb, nb}) : acc[ai][bj][m][0] * sc, v1 = AI ? __builtin_elementwise_fma(acc[ai][bj][m][1], (f32x4){sc, sc, sc, sc}, (f32x4){nb, nb, nb, nb}) : acc[ai][bj][m][1] * sc;
                    f32x4 s0 = v0, s1 = v1;
                    if (u.pn >= sig_from) {
                        const float sc2 = -LOG2E * sc, nb2 = -LOG2E * nb;
                        const f32x4 t0 = AI ? __builtin_elementwise_fma(acc[ai][bj][m][0], (f32x4){sc2, sc2, sc2, sc2}, (f32x4){nb2, nb2, nb2, nb2}) : acc[ai][bj][m][0] * sc2, t1 = AI ? __builtin_elementwise_fma(acc[ai][bj][m][1], (f32x4){sc2, sc2, sc2, sc2}, (f32x4){nb2, nb2, nb2, nb2}) : acc[ai][bj][m][1] * sc2;
                        const f32x4 d0 = (f32x4){__builtin_amdgcn_exp2f(t0[0]), __builtin_amdgcn_exp2f(t0[1]), __builtin_amdgcn_exp2f(t0[2]), __builtin_amdgcn_exp2f(t0[3])} + 1.f, d1 = (f32x4){__builtin_amdgcn_exp2f(t1[0]), __builtin_amdgcn_exp2f(t1[1]), __builtin_amdgcn_exp2f(t1[2]), __builtin_amdgcn_exp2f(t1[3])} + 1.f;
                        s0 = (f32x4){__builtin_amdgcn_rcpf(d0[0]), __builtin_amdgcn_rcpf(d0[1]), __builtin_amdgcn_rcpf(d0[2]), __builtin_amdgcn_rcpf(d0[3])}; s1 = (f32x4){__builtin_amdgcn_rcpf(d1[0]), __builtin_amdgcn_rcpf(d1[1]), __builtin_amdgcn_rcpf(d1[2]), __builtin_amdgcn_rcpf(d1[3])}; }
                    u32x4 w; w.x = cvt_pk_bf16(s0[0], s0[1]); w.y = cvt_pk_bf16(s0[2], s0[3]); w.z = cvt_pk_bf16(s1[0], s1[1]); w.w = cvt_pk_bf16(s1[2], s1[3]);
                    __builtin_nontemporal_store(w, (u32x4*)(rowp + bj * HALF)); } }
    }
};
struct EpiMerge {
    static constexpr bool PERM = true; static constexpr int MID_T = 8; static constexpr bool HAS_PRE = false; static constexpr bool MAGIC = false;
    const bf16* proj; bf16* Y;
    __device__ __forceinline__ void mid(Acc& acc, const Unit& u, int wr, int wc, int fr, int fq) const {
        int row0 = u.pm * BM + wr * 64 + fr, col0 = u.pn * BM + wc * 32 + 8 * fq;
        asm volatile("" : "+v"(row0), "+v"(col0));
        u32x4 ga[2][2], gb[2][2];
#define MG_LOAD(g, buf) do { const bf16* rp_ = proj + (size_t)(row0 + ((g) >> 2) * HALF + ((g) & 3) * 16) * DIN + col0; \
            ga[buf][0] = *(const u32x4*)(rp_ + C_GA); ga[buf][1] = *(const u32x4*)(rp_ + C_GA + HALF); gb[buf][0] = *(const u32x4*)(rp_ + C_GB); gb[buf][1] = *(const u32x4*)(rp_ + C_GB + HALF); } while (0)
        MG_LOAD(0, 0);
#pragma unroll
        for (int g = 0; g < 8; ++g) { const int ai = g >> 2, m = g & 3, cur = g & 1;
            if (g < 7) MG_LOAD(g + 1, cur ^ 1);
            asm volatile("" ::: "memory");
#pragma unroll
            for (int bj = 0; bj < 2; ++bj) { const u32x4 a = ga[cur][bj], b = gb[cur][bj]; float r[8];
#pragma unroll
                for (int q = 0; q < 4; ++q) { r[2 * q] = bflo(a[q]) * __builtin_amdgcn_rcpf(bflo(b[q])); r[2 * q + 1] = bfhi(a[q]) * __builtin_amdgcn_rcpf(bfhi(b[q])); }
                acc[ai][bj][m][0] = acc[ai][bj][m][0] * (f32x4){r[0], r[1], r[2], r[3]}; acc[ai][bj][m][1] = acc[ai][bj][m][1] * (f32x4){r[4], r[5], r[6], r[7]}; }
            asm volatile("" : "+v"(acc[ai][0][m][0]), "+v"(acc[ai][0][m][1]), "+v"(acc[ai][1][m][0]), "+v"(acc[ai][1][m][1]) :: "memory"); }
#undef MG_LOAD
    }
    __device__ __forceinline__ void operator()(const Acc& acc, const Unit& u, int wr, int wc, int fr, int fq) const {
        const int row0 = u.pm * BM + wr * 64 + fr, col0 = u.pn * BM + wc * 32 + 8 * fq;
#pragma unroll
        for (int ai = 0; ai < 2; ++ai)
#pragma unroll
            for (int m = 0; m < 4; ++m) { const size_t row = (size_t)(row0 + ai * HALF + m * 16);
#pragma unroll
                for (int bj = 0; bj < 2; ++bj) { const u32x4 b = *(const u32x4*)(proj + row * DIN + C_GB + col0 + bj * HALF);
                    const f32x4 v0 = acc[ai][bj][m][0], v1 = acc[ai][bj][m][1];
                    u32x4 w; w.x = cvt_pk_bf16(v0[0] * bflo(b.x), v0[1] * bfhi(b.x)); w.y = cvt_pk_bf16(v0[2] * bflo(b.y), v0[3] * bfhi(b.y));
                    w.z = cvt_pk_bf16(v1[0] * bflo(b.z), v1[1] * bfhi(b.z)); w.w = cvt_pk_bf16(v1[2] * bflo(b.w), v1[3] * bfhi(b.w));
                    *(u32x4*)(Y + row * D + col0 + bj * HALF) = w; } }
    }
};
template <bool BF32> struct EpiRes {
    static constexpr bool PERM = false; static constexpr int MID_T = 0; static constexpr bool HAS_PRE = false; static constexpr bool MAGIC = false;
    const void* base; bf16* out; const float* gate; float asc;
    __device__ __forceinline__ void mid(Acc&, const Unit&, int, int, int, int) const {}
    __device__ __forceinline__ void operator()(const Acc& acc, const Unit& u, int wr, int wc, int fr, int fq) const {
        const int b = (u.pm * BM) / SEQ, col0 = u.pn * BM + wc * 32 + 4 * fq;
        f32x4 gv[2][2];
#pragma unroll
        for (int bj = 0; bj < 2; ++bj)
#pragma unroll
            for (int n = 0; n < 2; ++n) gv[bj][n] = *(const f32x4*)(gate + (size_t)b * ADA_N + col0 + bj * HALF + n * 16) * asc;
#pragma unroll
        for (int ai = 0; ai < 2; ++ai)
#pragma unroll
            for (int m = 0; m < 4; ++m) { const size_t off = (size_t)(u.pm * BM + ai * HALF + wr * 64 + m * 16 + fr) * D + col0;
#pragma unroll
                for (int bj = 0; bj < 2; ++bj)
#pragma unroll
                    for (int n = 0; n < 2; ++n) { f32x4 bs;
                        if constexpr (BF32) bs = *(const f32x4*)((const float*)base + off + bj * HALF + n * 16);
                        else { const u32x2 w = *(const u32x2*)((const bf16*)base + off + bj * HALF + n * 16); bs = (f32x4){bflo(w.x), bfhi(w.x), bflo(w.y), bfhi(w.y)}; }
                        const f32x4 o = bs + gv[bj][n] * acc[ai][bj][m][n];
                        u32x2 w; w.x = cvt_pk_bf16(o[0], o[1]); w.y = cvt_pk_bf16(o[2], o[3]); *(u32x2*)(out + off + bj * HALF + n * 16) = w; } }
    }
};
template <bool F8O, bool AI = false> struct EpiSwiglu {
    static constexpr bool PERM = true; static constexpr int MID_T = 0; static constexpr bool HAS_PRE = true; static constexpr bool MAGIC = AI;
    void* Hd; int ldh, nN; float asc; const float* rs; const int* rl;
    __device__ __forceinline__ void mid(Acc&, const Unit&, int, int, int, int) const {}
    __device__ __forceinline__ void prefetch(const Unit& u, int wr, int fr, float (&p)[8]) const {
        if (rs) {
#pragma unroll
            for (int i = 0; i < 8; ++i) { const int rr_ = u.pm * BM + wr * 64 + fr + (i >> 2) * HALF + (i & 3) * 16; p[i] = rs[rl ? rl[rr_] : rr_]; } } }
    __device__ __forceinline__ void operator()(const Acc& acc, const Unit& u, int wr, int wc, int fr, int fq, const float* pre = nullptr) const {
        const int row0 = u.pm * BM + wr * 64 + fr, col0 = (u.pn - u.e * nN) * HALF + wc * 32 + 8 * fq;
#pragma unroll
        for (int ai = 0; ai < 2; ++ai)
#pragma unroll
            for (int m = 0; m < 4; ++m) { float h[8]; const int rr_ = row0 + ai * HALF + m * 16; const float sc = rs ? asc * (pre ? pre[ai * 4 + m] : rs[rl ? rl[rr_] : rr_]) : asc; const float nb = AI ? -FMAGIC * sc : 0.f, sc2 = -LOG2E * sc, nb2 = -LOG2E * nb;
#pragma unroll
                for (int n = 0; n < 2; ++n) { const f32x4 av = AI ? __builtin_elementwise_fma(acc[ai][0][m][n], (f32x4){sc, sc, sc, sc}, (f32x4){nb, nb, nb, nb}) : acc[ai][0][m][n] * sc, gv = AI ? __builtin_elementwise_fma(acc[ai][1][m][n], (f32x4){sc, sc, sc, sc}, (f32x4){nb, nb, nb, nb}) : acc[ai][1][m][n] * sc;
                    const f32x4 tv = AI ? __builtin_elementwise_fma(acc[ai][0][m][n], (f32x4){sc2, sc2, sc2, sc2}, (f32x4){nb2, nb2, nb2, nb2}) : acc[ai][0][m][n] * sc2;
                    const f32x4 dv = (f32x4){__builtin_amdgcn_exp2f(tv[0]), __builtin_amdgcn_exp2f(tv[1]), __builtin_amdgcn_exp2f(tv[2]), __builtin_amdgcn_exp2f(tv[3])} + 1.f;
                    const f32x4 hv = (av * gv) * (f32x4){__builtin_amdgcn_rcpf(dv[0]), __builtin_amdgcn_rcpf(dv[1]), __builtin_amdgcn_rcpf(dv[2]), __builtin_amdgcn_rcpf(dv[3])};
#pragma unroll
                    for (int q = 0; q < 4; ++q) h[4 * n + q] = hv[q]; }
                if constexpr (F8O) { u32x2 w; w.x = pk4_fp8(h[0], h[1], h[2], h[3]); w.y = pk4_fp8(h[4], h[5], h[6], h[7]);
                    __builtin_nontemporal_store(w, (u32x2*)((unsigned char*)Hd + (size_t)(row0 + ai * HALF + m * 16) * ldh + col0)); }
                else { u32x4 w; w.x = cvt_pk_bf16(h[0], h[1]); w.y = cvt_pk_bf16(h[2], h[3]); w.z = cvt_pk_bf16(h[4], h[5]); w.w = cvt_pk_bf16(h[6], h[7]);
                    __builtin_nontemporal_store(w, (u32x4*)((bf16*)Hd + (size_t)(row0 + ai * HALF + m * 16) * ldh + col0)); } }
    }
};
template <bool LAST> struct EpiMoeDown {
    static constexpr bool PERM = false; static constexpr int MID_T = 0; static constexpr bool HAS_PRE = false; static constexpr bool MAGIC = false;
    bf16* x; float* out; const float* gate; const int* list; const float* wl; float asc;
    __device__ __forceinline__ void mid(Acc&, const Unit&, int, int, int, int) const {}
    __device__ __forceinline__ void operator()(const Acc& acc, const Unit& u, int wr, int wc, int fr, int fq) const {
        const int col0 = (u.pn - u.e * 4) * BM + wc * 32 + 4 * fq;
#pragma unroll
        for (int ai = 0; ai < 2; ++ai)
#pragma unroll
            for (int m = 0; m < 4; ++m) { const int lr = ai * HALF + wr * 64 + m * 16 + fr;
                if (lr < u.nvalid) { const int sr = u.pm * BM + lr; const int tok = list[sr]; const float w = wl[sr] * asc; const int b = tok / SEQ;
                    bf16* xr = x + (size_t)tok * D + col0; float* orow = out + (size_t)tok * D + col0; const float* gr = gate + (size_t)b * ADA_N + col0;
#pragma unroll
                    for (int bj = 0; bj < 2; ++bj)
#pragma unroll
                        for (int n = 0; n < 2; ++n) { const f32x4 gv = *(const f32x4*)(gr + bj * HALF + n * 16); const u32x2 xw = *(const u32x2*)(xr + bj * HALF + n * 16);
                            const f32x4 o = (f32x4){bflo(xw.x), bfhi(xw.x), bflo(xw.y), bfhi(xw.y)} + gv * w * acc[ai][bj][m][n];
                            if constexpr (LAST) *(f32x4*)(orow + bj * HALF + n * 16) = o;
                            else { u32x2 ow; ow.x = cvt_pk_bf16(o[0], o[1]); ow.y = cvt_pk_bf16(o[2], o[3]); *(u32x2*)(xr + bj * HALF + n * 16) = ow; } } } }
    }
};

template <class Epi, class Sched, class AOff, bool ALIGN_EPI, int QM = 0>
__device__ __forceinline__ void gemm_phase(LAS unsigned char* lds, const Gemm g, const Sched& S, const AOff& AO, const Epi& E) {
    constexpr bool GA = AOff::GATHER; constexpr bool F8 = QM == 1; constexpr bool MB = (QM == 2) && Epi::MAGIC;
    int tid_ = threadIdx.x; asm volatile("" : "+v"(tid_));
    const int tid = tid_, wid = __builtin_amdgcn_readfirstlane(tid >> 6), lane = tid & 63, wr = wid >> 2, wc = wid & 3, fr = lane & 15, fq = lane >> 4;
    const int K = g.K, nt = K / BK;
    unsigned voffA[2], voffB[2];
#pragma unroll
    for (int i = 0; i < 2; ++i) { int R, C; stage_rc(tid * 16 + i * 8192, R, C); const int Rb = Epi::PERM ? ((R & ~31) + perm32(R & 31)) : R; voffA[i] = (unsigned)(R * K + C) * 2u; voffB[i] = (unsigned)(Rb * K + C) * 2u; }
    const size_t kstep = (size_t)(BK * 2);
    const size_t hstep = (size_t)HALF * K * 2;
    const size_t tstep = 2 * hstep;
    const unsigned ldsw = (unsigned)wid * 1024u;
    const int aoff = lds_byte(wr * 64 + fr, fq * 8), boff = lds_byte(wc * 32 + fr, fq * 8);
#define PG8_SA(b, h) (((b) * 2 + (h)) * HTB)
#define PG8_SB(b, h) ((4 + (b) * 2 + (h)) * HTB)
#define PG8_STAGE(bufoff, gbase, voff) do { _Pragma("unroll") for (int _i = 0; _i < 2; ++_i) \
        __builtin_amdgcn_global_load_lds((const unsigned*)((const char*)(gbase) + (voff)[_i]), (LAS unsigned*)(lds + (bufoff) + ldsw + _i * 8192), 16, 0, 0); } while (0)
#define PG8_STAGE_A(bufoff, ub, h) do { if constexpr (GA) { PG8_STAGE(bufoff, ub, gOff[h]); } else { PG8_STAGE(bufoff, (ub) + (h) * hstep, voffA); } } while (0)
#define PG8_LD2(dst, addr) do { const u32x4 lo_ = *(const LAS u32x4*)(addr), hi_ = *(const LAS u32x4*)((addr) + 1024); dst = (Frag){lo_.x, lo_.y, lo_.z, lo_.w, hi_.x, hi_.y, hi_.z, hi_.w}; } while (0)
#define PG8_LDA(dst, b, h) do { _Pragma("unroll") for (int m = 0; m < 4; ++m) PG8_LD2(dst[m], lds + PG8_SA(b, h) + aoff + m * 2048); } while (0)
#define PG8_LDB(dst, b, h) do { _Pragma("unroll") for (int n = 0; n < 2; ++n) PG8_LD2(dst[n], lds + PG8_SB(b, h) + boff + n * 2048); } while (0)
#define PG8_HALF(x, k) __builtin_bit_cast(bf16x8, (u32x4){x[4 * (k)], x[4 * (k) + 1], x[4 * (k) + 2], x[4 * (k) + 3]})
#define PG8_MMA(ai, bj, At, Bt) do { __builtin_amdgcn_s_setprio(1); if constexpr (F8) { _Pragma("unroll") for (int m = 0; m < 4; ++m) _Pragma("unroll") for (int n = 0; n < 2; ++n) \
        asm volatile("v_mfma_scale_f32_16x16x128_f8f6f4 %0, %1, %2, %0, %3, %3 op_sel_hi:[0,0,0]" : "+v"(acc[ai][bj][m][n]) : "v"(Bt[n]), "v"(At[m]), "v"(sc1)); } else { \
        _Pragma("unroll") for (int m = 0; m < 4; ++m) _Pragma("unroll") for (int n = 0; n < 2; ++n) _Pragma("unroll") for (int k = 0; k < 2; ++k) \
        { if constexpr (QM == 2) acc[ai][bj][m][n] = __builtin_bit_cast(f32x4, __builtin_amdgcn_mfma_i32_16x16x64_i8(__builtin_bit_cast(v4i, PG8_HALF(Bt[n], k)), __builtin_bit_cast(v4i, PG8_HALF(At[m], k)), __builtin_bit_cast(v4i, acc[ai][bj][m][n]), 0, 0, 0)); \
          else acc[ai][bj][m][n] = __builtin_amdgcn_mfma_f32_16x16x32_bf16(PG8_HALF(Bt[n], k), PG8_HALF(At[m], k), acc[ai][bj][m][n], 0, 0, 0); } } __builtin_amdgcn_s_setprio(0); } while (0)
#define PG8_WAIT_V(n) asm volatile("s_waitcnt vmcnt(" #n ")" ::: "memory")
#define PG8_WAIT_L(n) asm volatile("s_waitcnt lgkmcnt(" #n ")" ::: "memory")
#define PG8_BAR __builtin_amdgcn_s_barrier()
#define PG8_SCHED __builtin_amdgcn_sched_barrier(0)
    Unit cur, nxt; int ui = 0;
    if (!S.next(0, cur)) return;
    unsigned gOff[2][2];
    if constexpr (GA) AO.get(cur, tid, K, gOff);
    Acc acc;
#pragma unroll
    for (int a = 0; a < 2; ++a)
#pragma unroll
        for (int b = 0; b < 2; ++b)
#pragma unroll
            for (int m = 0; m < 4; ++m)
#pragma unroll
                for (int n = 0; n < 2; ++n) { if constexpr (MB) acc[a][b][m][n] = __builtin_bit_cast(f32x4, (v4i){IMAGIC, IMAGIC, IMAGIC, IMAGIC}); else acc[a][b][m][n] = (f32x4){0.f, 0.f, 0.f, 0.f}; if constexpr (QM == 2) asm volatile("" : "+v"(acc[a][b][m][n])); }
    typedef unsigned Frag __attribute__((ext_vector_type(8)));
    Frag At[4], B0[2], B1[2];
    unsigned sc1 = 0x7F7F7F7Fu; asm volatile("" : "+v"(sc1));
    const char* cA = (const char*)g.A + (GA ? (size_t)0 : (size_t)cur.pm * tstep); const char* cB = (const char*)g.Bt + (size_t)cur.pn * tstep;
    PG8_STAGE(PG8_SB(0, 0), cB, voffB); PG8_STAGE(PG8_SB(0, 1), cB + hstep, voffB); PG8_STAGE_A(PG8_SA(0, 0), cA, 0); PG8_STAGE_A(PG8_SA(0, 1), cA, 1);
    if (wr == 1) PG8_BAR;
    PG8_WAIT_V(2); PG8_BAR;
    PG8_STAGE(PG8_SB(1, 0), cB + kstep, voffB); PG8_STAGE_A(PG8_SA(1, 0), cA + kstep, 0); PG8_STAGE(PG8_SB(1, 1), cB + hstep + kstep, voffB);
    PG8_WAIT_V(6); PG8_BAR;
    for (;;) {
        const bool has_next = S.next(ui + 1, nxt);
        float pre[8];
        int nrow[2][2]; if constexpr (GA) { if (has_next) AO.rows(nxt, tid, nrow); }
        const char* nA = (GA || !has_next) ? cA : (const char*)g.A + (size_t)nxt.pm * tstep; const char* nB = has_next ? (const char*)g.Bt + (size_t)nxt.pn * tstep : cB;
#pragma nounroll
        for (int t = 0; t < nt; t += 2) {
            if (Epi::MID_T != 0 && t == Epi::MID_T) E.mid(acc, cur, wr, wc, fr, fq);
            const bool last = (t == nt - 2);
            const char* a1 = cA + (size_t)(t + 1) * kstep;
            PG8_LDB(B0, 0, 0); PG8_LDB(B1, 0, 1); PG8_SCHED; PG8_LDA(At, 0, 0); PG8_STAGE_A(PG8_SA(1, 1), a1, 1);
            if (last) { cA = nA; if constexpr (GA) { if (has_next) AO.offs(nrow, tid, K, gOff); } }
            if constexpr (Epi::HAS_PRE) { if (last) E.prefetch(cur, wr, fr, pre); }
            const char* a2 = last ? cA : cA + (size_t)(t + 2) * kstep; const char* b2 = last ? nB : cB + (size_t)(t + 2) * kstep;
            const char* a3 = a2 + kstep; const char* b3 = b2 + kstep;
            PG8_WAIT_V(8); PG8_WAIT_L(0); PG8_BAR; PG8_MMA(0, 0, At, B0); PG8_MMA(0, 1, At, B1); PG8_BAR; PG8_SCHED;
            PG8_LDA(At, 0, 1); PG8_STAGE(PG8_SB(0, 0), b2, voffB); PG8_STAGE(PG8_SB(0, 1), b2 + hstep, voffB); PG8_STAGE_A(PG8_SA(0, 0), a2, 0);
            PG8_WAIT_V(8); PG8_WAIT_L(0); PG8_BAR; PG8_MMA(1, 0, At, B0); PG8_MMA(1, 1, At, B1); PG8_BAR; PG8_SCHED;
            PG8_LDB(B0, 1, 0); PG8_LDB(B1, 1, 1); PG8_SCHED; PG8_LDA(At, 1, 0); PG8_STAGE_A(PG8_SA(0, 1), a2, 1);
            PG8_WAIT_V(8); PG8_WAIT_L(0); PG8_BAR; PG8_MMA(0, 0, At, B0); PG8_MMA(0, 1, At, B1); PG8_BAR; PG8_SCHED;
            PG8_LDA(At, 1, 1); PG8_STAGE(PG8_SB(1, 0), b3, voffB); PG8_STAGE(PG8_SB(1, 1), b3 + hstep, voffB); PG8_STAGE_A(PG8_SA(1, 0), a3, 0);
            PG8_WAIT_V(8); PG8_WAIT_L(0); PG8_BAR; PG8_MMA(1, 0, At, B0); PG8_MMA(1, 1, At, B1); PG8_BAR; PG8_SCHED;
        }
        if constexpr (F8) asm volatile("s_nop 15\n\ts_nop 15" ::: "memory");
        if constexpr (ALIGN_EPI) { if (wr == 0) PG8_BAR; }
        if constexpr (QM == 2 && !MB) {
#pragma unroll
            for (int a = 0; a < 2; ++a)
#pragma unroll
                for (int b = 0; b < 2; ++b)
#pragma unroll
                    for (int m = 0; m < 4; ++m)
#pragma unroll
                        for (int n = 0; n < 2; ++n) acc[a][b][m][n] = acc_i2f(acc[a][b][m][n]); }
        { int te_ = threadIdx.x; asm volatile("" : "+v"(te_));
          const int le_ = te_ & 63; if constexpr (Epi::HAS_PRE) E(acc, cur, wr, wc, le_ & 15, le_ >> 4, pre); else E(acc, cur, wr, wc, le_ & 15, le_ >> 4); }
        if (!has_next) break;
#pragma unroll
        for (int a = 0; a < 2; ++a)
#pragma unroll
            for (int b = 0; b < 2; ++b)
#pragma unroll
                for (int m = 0; m < 4; ++m)
#pragma unroll
                    for (int n = 0; n < 2; ++n) { if constexpr (MB) acc[a][b][m][n] = __builtin_bit_cast(f32x4, (v4i){IMAGIC, IMAGIC, IMAGIC, IMAGIC}); else acc[a][b][m][n] = (f32x4){0.f, 0.f, 0.f, 0.f}; if constexpr (QM == 2) asm volatile("" : "+v"(acc[a][b][m][n])); }
        cur = nxt; cB = nB; ++ui;
        if constexpr (ALIGN_EPI) { if (wr == 1) PG8_BAR; }
    }
    PG8_WAIT_V(0);
    if constexpr (!ALIGN_EPI) { if (wr == 0) PG8_BAR; }
    PG8_BAR;
#undef PG8_SA
#undef PG8_SB
#undef PG8_STAGE
#undef PG8_STAGE_A
#undef PG8_LDA
#undef PG8_LDB
#undef PG8_MMA
#undef PG8_HALF
#undef PG8_LD2
#undef PG8_WAIT_V
#undef PG8_WAIT_L
#undef PG8_BAR
#undef PG8_SCHED
}
}

#define XB_TMO      128
#define XB_XCNT(j)  (256  + 64 * (j))
#define XB_XSUB(j)  (1280 + 64 * (j))
#define XB_XGEN(j)  (2304 + 64 * (j))
#define XB_TOP      3328
#define XB_TOPGEN   3392
#define XCD_BAR_WORDS 3456
#define XB_SPIN_CAP (1u << 23)
__device__ __forceinline__ unsigned xb_ld(unsigned* p)              { return __hip_atomic_load(p, __ATOMIC_RELAXED, __HIP_MEMORY_SCOPE_AGENT); }
__device__ __forceinline__ unsigned xb_add(unsigned* p, unsigned v) { return __hip_atomic_fetch_add(p, v, __ATOMIC_RELAXED, __HIP_MEMORY_SCOPE_AGENT); }
__device__ __forceinline__ unsigned xb_xcc_id() { return (unsigned)__builtin_amdgcn_s_getreg((3 << 11) | 20) & 0xFu; }
#define XB_SPIN(cond, bar) do { unsigned _sp = 0; while (cond) { __builtin_amdgcn_s_sleep(1); \
    if ((++_sp & 255u) == 0u) { if (xb_ld(&(bar)[XB_TMO])) break; if (_sp > XB_SPIN_CAP) { atomicAdd(&(bar)[XB_TMO], 1u); break; } } } } while (0)
struct XcdBarrier { unsigned* bar; unsigned x; volatile LAS unsigned* st; };
__device__ __forceinline__ XcdBarrier xcd_barrier_post(unsigned* bar, volatile LAS unsigned* st) {
    XcdBarrier b; b.bar = bar; b.x = xb_xcc_id(); b.st = st;
    if (threadIdx.x == 0) (void)xb_add(&bar[XB_XCNT(b.x)], 1u);
    return b;
}
__device__ __forceinline__ void xcd_barrier_complete(unsigned* bar, unsigned x, unsigned& nloc, unsigned& nx) {
    const unsigned G = gridDim.x * gridDim.y * gridDim.z;
    unsigned sum, cnt, mine, sp = 0u;
    for (;;) {
        sum = 0u; cnt = 0u; mine = 0u;
#pragma unroll
        for (unsigned j = 0; j < 16; ++j) { const unsigned c = xb_ld(&bar[XB_XCNT(j)]); sum += c; cnt += (c > 0u) ? 1u : 0u; mine = (j == x) ? c : mine; }
        if (sum == G) break;
        __builtin_amdgcn_s_sleep(1);
        if ((++sp & 255u) == 0u) { if (xb_ld(&bar[XB_TMO])) break; if (sp > XB_SPIN_CAP) { atomicAdd(&bar[XB_TMO], 1u); break; } }
    }
    nloc = mine > 0u ? mine : 1u; nx = cnt > 0u ? cnt : 1u;
}
__device__ __forceinline__ void xcd_barrier(const XcdBarrier& b) {
    asm volatile("s_waitcnt vmcnt(0)" ::: "memory");
    __syncthreads();
    if (threadIdx.x == 0) {
        unsigned* bar = b.bar; unsigned bx_ = __builtin_amdgcn_readfirstlane(b.x);
        asm volatile("" : "+s"(bar), "+s"(bx_));
        __builtin_amdgcn_s_waitcnt(0);
        unsigned nloc = b.st[0], nx = b.st[1];
        if (nloc == 0u) { xcd_barrier_complete(bar, bx_, nloc, nx); b.st[0] = nloc; b.st[1] = nx; }
        const unsigned old = xb_add(&bar[XB_XSUB(bx_)], 1u);
        const unsigned gen = old / nloc;
        if (old + 1u == (gen + 1u) * nloc) {
            __builtin_amdgcn_fence(__ATOMIC_RELEASE, "agent");
            asm volatile("s_waitcnt vmcnt(0)" ::: "memory");
            const unsigned og = xb_add(&bar[XB_TOP], 1u);
            const unsigned tg = og / nx;
            if (og + 1u == (tg + 1u) * nx) xb_add(&bar[XB_TOPGEN], 1u);
            else XB_SPIN(xb_ld(&bar[XB_TOPGEN]) == tg, bar);
            __builtin_amdgcn_fence(__ATOMIC_ACQUIRE, "agent");
            xb_add(&bar[XB_XGEN(bx_)], 1u);
            asm volatile("s_waitcnt vmcnt(0)" ::: "memory");
        } else {
            XB_SPIN(xb_ld(&bar[XB_XGEN(bx_)]) == gen, bar);
            __builtin_amdgcn_fence(__ATOMIC_ACQUIRE, "agent");
            asm volatile("s_waitcnt vmcnt(0)" ::: "memory");
        }
    }
    __syncthreads();
}

struct Frame {
    LAS unsigned char* lds;
    volatile LAS unsigned* LC;
    gu32* ctl;
    int tid, lane, wave, vcu, G, bx;
    unsigned char* ws;
    float* adaf;
};

__device__ __forceinline__ void transpose_item(const float* W, int N, bf16* WT, int ldk, int koff, int mode, LAS float* scr, int item, int lane) {
    const int nblk = N / 32, kb = item / nblk, nb = item % nblk, k0 = 64 * kb, n0 = 32 * nb;
#pragma unroll 8
    for (int i = 0; i < 32; ++i) { const int kk = 2 * i + (lane >> 5); scr[kk * 33 + (lane & 31)] = W[(size_t)(k0 + kk) * N + n0 + (lane & 31)]; }
    LDS_WAIT(); asm volatile("" ::: "memory");
    const int c = lane & 7;
    const int d0 = mode == 0 ? n0 : ((n0 >> 7) * 256 + (mode == 2 ? 128 : 0) + (n0 & 127));
#pragma unroll
    for (int j = 0; j < 4; ++j) { const int n = (lane >> 3) + 8 * j; const LAS float* s = scr + (8 * c) * 33 + n;
        u32x4 o; o.x = pk2(s[0 * 33], s[1 * 33]); o.y = pk2(s[2 * 33], s[3 * 33]); o.z = pk2(s[4 * 33], s[5 * 33]); o.w = pk2(s[6 * 33], s[7 * 33]);
        *(u32x4*)(WT + (size_t)(d0 + n) * ldk + koff + k0 + 8 * c) = o; }
    LDS_WAIT(); asm volatile("" ::: "memory");
}

#define PHASE_ENTER(F) do { int t_ = threadIdx.x; asm volatile("" : "+v"(t_)); (F).tid = t_; (F).lane = t_ & 63; (F).wave = __builtin_amdgcn_readfirstlane(t_ >> 6); \
    int b_ = blockIdx.x; asm volatile("" : "+s"(b_)); (F).bx = b_; (F).vcu = ((F).G % 8 == 0) ? (b_ % 8) * ((F).G / 8) + b_ / 8 : b_; } while (0)
__device__ __forceinline__ void transpose_item_f8(const float* W, int N, unsigned char* WT, int ldk, int koff, int mode, LAS float* scr, int item, int lane, int nblk_ = 0) {
    const int nblk = nblk_ ? nblk_ : N / 32, kb = item / nblk, nb = item % nblk, k0 = 64 * kb, n0 = 32 * nb;
#pragma unroll 8
    for (int i = 0; i < 32; ++i) { const int kk = 2 * i + (lane >> 5); scr[kk * 33 + (lane & 31)] = W[(size_t)(k0 + kk) * N + n0 + (lane & 31)] * W8_SCALE; }
    LDS_WAIT(); asm volatile("" ::: "memory");
    const int c = lane & 7;
    const int d0 = mode == 0 ? n0 : ((n0 >> 7) * 256 + (mode == 2 ? 128 : 0) + (n0 & 127));
#pragma unroll
    for (int j = 0; j < 4; ++j) { const int n = (lane >> 3) + 8 * j; const LAS float* sp = scr + (8 * c) * 33 + n;
        u32x2 o; o.x = pk4_fp8(sp[0 * 33], sp[1 * 33], sp[2 * 33], sp[3 * 33]); o.y = pk4_fp8(sp[4 * 33], sp[5 * 33], sp[6 * 33], sp[7 * 33]);
        *(u32x2*)(WT + (size_t)(d0 + n) * ldk + koff + k0 + 8 * c) = o; }
    LDS_WAIT(); asm volatile("" ::: "memory");
}
__device__ __forceinline__ void transpose_item_i8(const float* W, int N, unsigned char* WT, int ldk, int koff, int mode, LAS float* scr, int item, int lane, int nblk_ = 0) {
    const int nblk = nblk_ ? nblk_ : N / 32, kb = item / nblk, nb = item % nblk, k0 = 64 * kb, n0 = 32 * nb;
#pragma unroll 8
    for (int i = 0; i < 32; ++i) { const int kk = 2 * i + (lane >> 5); scr[kk * 33 + (lane & 31)] = W[(size_t)(k0 + kk) * N + n0 + (lane & 31)] * QW_SCALE; }
    LDS_WAIT(); asm volatile("" ::: "memory");
    const int c = lane & 7;
    const int d0 = mode == 0 ? n0 : ((n0 >> 7) * 256 + (mode == 2 ? 128 : 0) + (n0 & 127));
#pragma unroll
    for (int j = 0; j < 4; ++j) { const int n = (lane >> 3) + 8 * j; const LAS float* sp = scr + (8 * c) * 33 + n;
        u32x2 o; o.x = pk4_i8(sp[0 * 33], sp[1 * 33], sp[2 * 33], sp[3 * 33]); o.y = pk4_i8(sp[4 * 33], sp[5 * 33], sp[6 * 33], sp[7 * 33]);
        *(u32x2*)(WT + (size_t)(d0 + n) * ldk + koff + k0 + 8 * c) = o; }
    LDS_WAIT(); asm volatile("" ::: "memory");
}
struct Args { const float* in[23]; float* out; unsigned char* ws; int pad0, pad1; };

__device__ __forceinline__ void phase_prologue(Frame& F, const Args& a, int part) {
    PHASE_ENTER(F);
    if (part == 0) {
    {
        LAS float* cs = (LAS float*)F.lds;
        LAS float* red = (LAS float*)(F.lds + 32768);
        if (F.bx < 2 * (ADA_N / 64)) {
            for (int i = F.tid; i < NB * D; i += NTHR) { const float c = a.in[1][i]; cs[i] = c * sigm(c); }
            __syncthreads();
            for (int it = F.bx; it < 2 * (ADA_N / 64); it += F.G) {
                const int l = it / (ADA_N / 64), j = (it % (ADA_N / 64)) * 64 + F.lane;
                const float* w = a.in[2] + (size_t)l * D * ADA_N + j;
                float acc[NB];
#pragma unroll
                for (int b = 0; b < NB; ++b) acc[b] = 0.f;
                for (int i = F.wave * 128; i < F.wave * 128 + 128; ++i) { const float wv = w[(size_t)i * ADA_N];
#pragma unroll
                    for (int b = 0; b < NB; ++b) acc[b] += cs[b * D + i] * wv; }
#pragma unroll
                for (int b = 0; b < NB; ++b) red[(F.wave * NB + b) * 64 + F.lane] = acc[b];
                __syncthreads();
                { const int b = F.tid >> 6, jj = F.tid & 63; float s = 0.f;
#pragma unroll
                  for (int w8 = 0; w8 < 8; ++w8) s += red[(w8 * NB + b) * 64 + jj];
                  const int col = (it % (ADA_N / 64)) * 64 + jj;
                  F.adaf[AO_ADA + ((size_t)l * NB + b) * ADA_N + col] = s + a.in[3][(size_t)l * ADA_N + col]; }
                __syncthreads();
            }
        }
        __syncthreads();
    }
    if (F.bx == F.G - 1) {
        { const int i = F.tid;
          const float l0 = a.in[7][i], l1 = a.in[7][512 + i];
          F.adaf[AO_LB + i] = 0.f; F.adaf[AO_LB + 512 + i] = 1.f / (1.f + __expf(l0 - l1)); }
        if (F.wave < 2) { const int l = F.wave; const float* lv = a.in[11] + l * 256;
            const float s1 = wave_sum(lv[F.lane] * lv[64 + F.lane]), s2 = wave_sum(lv[128 + F.lane] * lv[192 + F.lane]);
            const float li = 0.8f - 0.6f * __expf(-0.3f * (float)l);
            float mq = fabsf(a.in[9][l * 64 + F.lane]), mk = fabsf(a.in[10][l * 64 + F.lane]);
#pragma unroll
            for (int o = 1; o < 64; o <<= 1) { mq = fmaxf(mq, __shfl_xor(mq, o)); mk = fmaxf(mk, __shfl_xor(mk, o)); }
            const float B2 = 8.f * LOG2E * mq * mk * 1.05f;
            if (F.lane == 0) { F.adaf[AO_MISC + l * 8 + 0] = __expf(s1) - __expf(s2) + li; F.adaf[AO_MISC + l * 8 + 1] = li; F.adaf[AO_MISC + l * 8 + 2] = B2; }
            int cst[2], key[2];
#pragma unroll
            for (int e = 0; e < 2; ++e) { const int j = F.lane + 64 * e, h = j >> 5, qb = j & 31;
                const float win = (150.f + 2.f * B2) / (exp2f(-2.f * (float)(h + 1)) * LOG2E); const int wi = win < 8192.f ? (int)win + 1 : 8192;
                int ts = (128 * qb - wi) >> 6; if (ts < 0) ts = 0;
                cst[e] = 2 * qb + 2 - ts; key[e] = j; if (qb == 0 && F.lane < 64) F.adaf[AO_MISC + l * 8 + 3 + h] = (float)wi; }
            int rk[2] = {0, 0};
            for (int j2 = 0; j2 < 128; ++j2) { const int c2 = __shfl(cst[j2 >> 6], j2 & 63);
#pragma unroll
                for (int e = 0; e < 2; ++e) rk[e] += (c2 > cst[e] || (c2 == cst[e] && j2 < key[e])) ? 1 : 0; }
            int* ord = (int*)(F.adaf + AO_ORD) + l * 1024;
#pragma unroll
            for (int e = 0; e < 2; ++e) { const int h = key[e] >> 5, qb = key[e] & 31;
#pragma unroll
                for (int b = 0; b < NB; ++b) ord[rk[e] * 8 + b] = ((b * 4 + h) << 5) | qb; } }
    }
    }
    LAS float* scr = (LAS float*)(F.lds + F.wave * 16384);
    const int gw = F.vcu * NWAVES + F.wave, NGW = F.G * NWAVES;
    constexpr int I_IN = 16 * (DIN / 32), I_P = 8 * 32, I_O = 16 * 32, I_13 = 16 * (DFF / 32), I_2 = (DFF / 64) * 32;
    constexpr int I_G8a = 16 * (1024 / 32), I_G8 = 16 * (2560 / 32);
    constexpr int NIT = 2 * (I_IN + 2 * I_P + I_O) + 2 * I_13 + I_2;
    constexpr int NIT0 = I_IN + 2 * I_P + I_O;
    for (int it = (part == 0 ? 0 : NIT0) + gw; it < (part == 0 ? NIT0 : NIT); it += NGW) {
        int r = it; bool done = false;
#pragma unroll
        for (int l = 0; l < 2; ++l) {
            if (done) break;
            if (r < I_IN) { transpose_item_i8(a.in[6] + (size_t)l * D * DIN, DIN, a.ws + WS_WIN8 + (size_t)l * DIN * D, D, 0, 0, scr, r, F.lane); done = true; break; } r -= I_IN;
            if (r < I_P) { transpose_item(a.in[13] + (size_t)l * 512 * D, D, (bf16*)(a.ws + WS_WPAB) + (size_t)l * D * D, D, 0, 0, scr, r, F.lane); done = true; break; } r -= I_P;
            if (r < I_P) { transpose_item(a.in[14] + (size_t)l * 512 * D, D, (bf16*)(a.ws + WS_WPAB) + (size_t)l * D * D, D, 512, 0, scr, r, F.lane); done = true; break; } r -= I_P;
            if (r < I_O) { transpose_item(a.in[15] + (size_t)l * D * D, D, (bf16*)(a.ws + WS_WO) + (size_t)l * D * D, D, 0, 0, scr, r, F.lane); done = true; break; } r -= I_O;
        }
        if (done) continue;
        if (r < I_13) { transpose_item_i8(a.in[16], DFF, a.ws + WS_W13, D, 0, 1, scr, r, F.lane); continue; } r -= I_13;
        if (r < I_13) { transpose_item_i8(a.in[17], DFF, a.ws + WS_W13, D, 0, 2, scr, r, F.lane); continue; } r -= I_13;
        transpose_item(a.in[18], D, (bf16*)(a.ws + WS_W2), DFF, 0, 0, scr, r, F.lane);
    }
}
__device__ __forceinline__ void phase_moe_weights(Frame& F, const Args& a) {
    PHASE_ENTER(F);
    LAS float* scr = (LAS float*)(F.lds + F.wave * 16384);
    const int gw = F.vcu * NWAVES + F.wave, NGW = F.G * NWAVES;
    constexpr int I_1 = 16 * (DFFE / 32), I_2 = (DFFE / 64) * 32, PER_E = 2 * I_1 + I_2;
    for (int it = gw; it < NEXP * PER_E; it += NGW) {
        const int e = it / PER_E; int r = it % PER_E;
        if (r < I_1) { transpose_item_i8(a.in[20] + (size_t)e * D * DFFE, DFFE, a.ws + WS_MW13 + (size_t)e * 2 * DFFE * D, D, 0, 1, scr, r, F.lane); continue; } r -= I_1;
        if (r < I_1) { transpose_item_i8(a.in[21] + (size_t)e * D * DFFE, DFFE, a.ws + WS_MW13 + (size_t)e * 2 * DFFE * D, D, 0, 2, scr, r, F.lane); continue; } r -= I_1;
        transpose_item_f8(a.in[22] + (size_t)e * DFFE * D, D, a.ws + WS_MW2 + (size_t)e * D * DFFE, DFFE, 0, 0, scr, r, F.lane);
    }
}

template <bool MOE, int F8O, bool XB16>
__device__ __forceinline__ void phase_norm(Frame& F, const void* x, const float* gain, const float* ada_l, int sh_chunk, int sc_chunk, void* H, void* H2, float* rsv, const float* router, int* toke, float* tokw) {
    PHASE_ENTER(F);
    float rw[MOE ? 16 : 1][MOE ? 8 : 1];
    if constexpr (MOE) {
        for (int i = F.tid; i < 16; i += NTHR) F.LC[LC_LH + i] = 0u;
        __syncthreads();
#pragma unroll
        for (int j = 0; j < 4; ++j)
#pragma unroll
            for (int c = 0; c < 4; ++c) { const float* rp = router + (size_t)(256 * j + 4 * F.lane + c) * NEXP; const f32x4 r0 = *(const f32x4*)rp, r1 = *(const f32x4*)(rp + 4);
                rw[4 * j + c][0] = r0[0]; rw[4 * j + c][1] = r0[1]; rw[4 * j + c][2] = r0[2]; rw[4 * j + c][3] = r0[3]; rw[4 * j + c][4] = r1[0]; rw[4 * j + c][5] = r1[1]; rw[4 * j + c][6] = r1[2]; rw[4 * j + c][7] = r1[3]; }
    }
    const int rows_per = (M + F.G - 1) / F.G, r0 = F.bx * rows_per, r1 = (r0 + rows_per < M) ? r0 + rows_per : M;
    f32x4 nf[4]; u32x2 nh[4];
#define NORM_LOAD(mm) do { if ((mm) < r1) { _Pragma("unroll") for (int j = 0; j < 4; ++j) { if constexpr (XB16) nh[j] = ((const u32x2*)((const bf16*)x + (size_t)(mm) * D) + F.lane)[64 * j]; else nf[j] = ((const f32x4*)((const float*)x + (size_t)(mm) * D) + F.lane)[64 * j]; } } } while (0)
    NORM_LOAD(r0 + F.wave);
    for (int m = r0 + F.wave; m < r1; m += NWAVES) {
        const int b = m / SEQ;
        f32x4 v[4]; float s = 0.f;
#pragma unroll
        for (int j = 0; j < 4; ++j) { if constexpr (XB16) v[j] = (f32x4){bflo(nh[j].x), bfhi(nh[j].x), bflo(nh[j].y), bfhi(nh[j].y)}; else v[j] = nf[j]; }
        NORM_LOAD(m + NWAVES);
#pragma unroll
        for (int j = 0; j < 4; ++j) { s += (v[j].x * v[j].x + v[j].y * v[j].y) + (v[j].z * v[j].z + v[j].w * v[j].w); }
        const float rstd = 1.f / sqrtf(wave_sum(s) * (1.f / D) + EPS);
        const float* ab = ada_l + (size_t)b * ADA_N;
        f32x4 yv[4]; float amax = 0.f;
        u32x2* o8 = (u32x2*)((bf16*)H + (size_t)m * D) + F.lane; unsigned* o4 = (unsigned*)((unsigned char*)(F8O == 2 ? H2 : H) + (size_t)m * D) + F.lane;
        float lg[8];
#pragma unroll
        for (int e = 0; e < 8; ++e) lg[e] = 0.f;
#pragma unroll
        for (int j = 0; j < 4; ++j) { const int col = 256 * j + 4 * F.lane;
            const f32x4 g4 = *(const f32x4*)(gain + col), sc4 = *(const f32x4*)(ab + sc_chunk * D + col), sh4 = *(const f32x4*)(ab + sh_chunk * D + col);
            const f32x4 y = (v[j] * rstd * g4) * (sc4 + 1.f) + sh4; yv[j] = y; amax = fmaxf(fmaxf(amax, fmaxf(fabsf(y.x), fabsf(y.y))), fmaxf(fabsf(y.z), fabsf(y.w)));
            if constexpr (F8O != 1) { u32x2 w; w.x = pk2(y.x, y.y); w.y = pk2(y.z, y.w); o8[64 * j] = w; }
            if constexpr (MOE) {
#pragma unroll
                for (int c = 0; c < 4; ++c)
#pragma unroll
                    for (int e = 0; e < 8; ++e) lg[e] += y[c] * rw[4 * j + c][e]; } }
        if constexpr (F8O != 0) {
#pragma unroll
            for (int o = 1; o < 64; o <<= 1) amax = fmaxf(amax, __shfl_xor(amax, o));
            amax = fmaxf(amax, 1e-20f); const float qs = 127.f / amax;
#pragma unroll
            for (int j = 0; j < 4; ++j) o4[64 * j] = pk4_i8(yv[j].x * qs, yv[j].y * qs, yv[j].z * qs, yv[j].w * qs);
            if (F.lane == 0) rsv[m] = amax * (1.f / 127.f);
        }
        if constexpr (MOE) {
#pragma unroll
            for (int e = 0; e < 8; ++e) lg[e] = wave_sum(lg[e]);
            int e0 = 0; float v0 = lg[0];
#pragma unroll
            for (int e = 1; e < 8; ++e) if (lg[e] > v0) { v0 = lg[e]; e0 = e; }
            int e1 = -1; float v1 = 0.f;
#pragma unroll
            for (int e = 0; e < 8; ++e) if (e != e0 && (e1 < 0 || lg[e] > v1)) { v1 = lg[e]; e1 = e; }
            if (F.lane == 0) { const float w0 = 1.f / (1.f + __expf(v1 - v0));
                toke[2 * m] = e0; toke[2 * m + 1] = e1; tokw[2 * m] = w0; tokw[2 * m + 1] = 1.f - w0;
                lds_inc(&F.LC[LC_LH + e0]); lds_inc(&F.LC[LC_LH + 8 + e1]); }
        }
    }
    if constexpr (MOE) {
        __syncthreads();
        if (F.tid < 16) __hip_atomic_fetch_add(F.ctl + CW_MOE + F.tid * 64, F.LC[LC_LH + F.tid], RLX_AGENT);
    }
#undef NORM_LOAD
}
__device__ __forceinline__ void phase_moe_sort(Frame& F, const int* toke, const float* tokw, int* list, float* wl, const float* rs, float* rsl) {
    PHASE_ENTER(F);
    if (F.tid < 16) F.LC[LC_CNT + F.tid] = __hip_atomic_load(F.ctl + CW_MOE + F.tid * 64, RLX_AGENT);
    if (F.tid >= 64 && F.tid < 80) F.LC[LC_LH + F.tid - 64] = 0u;
    __syncthreads();
    if (F.tid < 2) { unsigned o = 0; for (int e = 0; e < 8; ++e) { F.LC[LC_TOFF + F.tid * 8 + e] = o; o += (F.LC[LC_CNT + F.tid * 8 + e] + 255u) >> 8; } F.LC[LC_TOT + F.tid] = o; }
    const int rows_per = (M + F.G - 1) / F.G, r0 = F.bx * rows_per, r1 = (r0 + rows_per < M) ? r0 + rows_per : M;
    int me[2] = {0, 0}, mr[2] = {0, 0};
    for (int base = r0; base < r1; base += NTHR) {
        const int m = base + F.tid;
        if (m < r1) { me[0] = toke[2 * m]; me[1] = toke[2 * m + 1];
            mr[0] = (int)lds_inc(&F.LC[LC_LH + me[0]]); mr[1] = (int)lds_inc(&F.LC[LC_LH + 8 + me[1]]); }
    }
    __syncthreads();
    if (F.tid < 16) F.LC[LC_BASE + F.tid] = __hip_atomic_fetch_add(F.ctl + CW_MOE + 1024 + F.tid * 64, F.LC[LC_LH + F.tid], RLX_AGENT);
    __syncthreads();
    { const int m = r0 + F.tid;
      if (m < r1) {
#pragma unroll
        for (int s = 0; s < 2; ++s) { const int row = (int)F.LC[LC_TOFF + s * 8 + me[s]] * 256 + (int)F.LC[LC_BASE + s * 8 + me[s]] + mr[s];
            list[s * MOE_ROWS + row] = m; wl[s * MOE_ROWS + row] = tokw[2 * m + s]; rsl[s * MOE_ROWS + row] = rs[m]; } } }
    if (F.bx < 16) { const int se = F.bx, s = se >> 3; const int cnt = (int)F.LC[LC_CNT + se], nt = (cnt + 255) >> 8, ro = (int)F.LC[LC_TOFF + se] * 256;
        for (int r = cnt + F.tid; r < nt * 256; r += NTHR) { list[s * MOE_ROWS + ro + r] = 0; wl[s * MOE_ROWS + ro + r] = 0.f; rsl[s * MOE_ROWS + ro + r] = 0.f; } }
    __syncthreads();
}

__device__ __forceinline__ void phase_qkprep(Frame& F, bf16* proj, const float* gq, const float* gk) {
    PHASE_ENTER(F);
    const int gw = F.vcu * NWAVES + F.wave, NGW = F.G * NWAVES;
    const int d0 = (F.lane & 7) * 8;
    float gqv[8], gkv[8];
#pragma unroll
    for (int i = 0; i < 8; ++i) { gqv[i] = gq[d0 + i] * (0.125f * LOG2E); gkv[i] = gk[d0 + i]; }
    for (int m = gw; m < M; m += NGW) {
#pragma unroll
        for (int which = 0; which < 2; ++which) {
            u32x4* p = (u32x4*)(proj + (size_t)m * DIN + (which ? C_DK : C_DQ)) + F.lane;
            const u32x4 w = *p; float v[8];
#pragma unroll
            for (int q = 0; q < 4; ++q) { v[2 * q] = bflo(w[q]); v[2 * q + 1] = bfhi(w[q]); }
            float s = 0.f;
#pragma unroll
            for (int i = 0; i < 8; ++i) s += v[i] * v[i];
            s += __shfl_xor(s, 1); s += __shfl_xor(s, 2); s += __shfl_xor(s, 4);
            const float rstd = 1.f / sqrtf(s * (1.f / 64.f) + EPS);
            u32x4 o;
#pragma unroll
            for (int q = 0; q < 4; ++q) o[q] = pk2(v[2 * q] * rstd * (which ? gkv[2 * q] : gqv[2 * q]), v[2 * q + 1] * rstd * (which ? gkv[2 * q + 1] : gqv[2 * q + 1]));
            *p = o;
        }
    }
}

__device__ __forceinline__ void phase_hgrn_naive(Frame& F, const bf16* proj, const float* lbv, const float* gn, bf16* ocat) {
    PHASE_ENTER(F);
    LAS float* Fs = (LAS float*)F.lds;
    LAS float* Ks = Fs + 2048; LAS float* Qs = Ks + 2048; LAS float* Vs = Qs + 2048; LAS float* Gs = Vs + 2048;
    LAS float* O4 = Gs + 2048;
    const int j = F.tid & 127, qr = F.tid >> 7;
    for (int it = F.bx; it < NB * 4; it += F.G) {
        const int b = it >> 2, h = it & 3;
        float S[32];
#pragma unroll
        for (int i = 0; i < 32; ++i) S[i] = 0.f;
        for (int t0 = 0; t0 < SEQ; t0 += 16) {
#pragma unroll
            for (int r = 0; r < 4; ++r) { const int idx = F.tid + NTHR * r, row = idx >> 7, col = idx & 127;
                const bf16* pr = proj + (size_t)(b * SEQ + t0 + row) * DIN + h * 128 + col;
                const float z = bf2f(pr[C_HF]), lb = lbv[h * 128 + col];
                Fs[idx] = lb + (1.f - lb) * sigm(z); Ks[idx] = (1.f - lb) * sigm(-z); Qs[idx] = bf2f(pr[C_HQ]); Vs[idx] = bf2f(pr[C_HI]); Gs[idx] = bf2f(pr[C_HG]); }
            __syncthreads();
            for (int tt = 0; tt < 16; ++tt) {
                const float v = Vs[tt * 128 + j]; float acc = 0.f;
#pragma unroll
                for (int i4 = 0; i4 < 8; ++i4) { const f32x4 f4 = *(const LAS f32x4*)(Fs + tt * 128 + qr * 32 + 4 * i4), k4 = *(const LAS f32x4*)(Ks + tt * 128 + qr * 32 + 4 * i4), q4 = *(const LAS f32x4*)(Qs + tt * 128 + qr * 32 + 4 * i4);
#pragma unroll
                    for (int c = 0; c < 4; ++c) { S[4 * i4 + c] = f4[c] * S[4 * i4 + c] + k4[c] * v; acc += S[4 * i4 + c] * q4[c]; } }
                O4[(qr * 16 + tt) * 128 + j] = acc;
            }
            __syncthreads();
#pragma unroll
            for (int rr = 0; rr < 2; ++rr) { const int tt = F.wave * 2 + rr;
                float o[2]; float ss = 0.f;
#pragma unroll
                for (int c = 0; c < 2; ++c) { const int jj = F.lane + 64 * c; o[c] = O4[(0 * 16 + tt) * 128 + jj] + O4[(1 * 16 + tt) * 128 + jj] + O4[(2 * 16 + tt) * 128 + jj] + O4[(3 * 16 + tt) * 128 + jj]; ss += o[c] * o[c]; }
                const float rstd = 1.f / sqrtf(wave_sum(ss) * (1.f / 128.f) + EPS);
#pragma unroll
                for (int c = 0; c < 2; ++c) { const int jj = F.lane + 64 * c; const float g = Gs[tt * 128 + jj];
                    ocat[(size_t)(b * SEQ + t0 + tt) * D + h * 128 + jj] = (bf16)f2bf(o[c] * rstd * gn[jj] * (g * sigm(g))); } }
            __syncthreads();
        }
    }
}

__device__ __forceinline__ void phase_attn_naive(Frame& F, const bf16* proj, bf16* tmp, const float* subg, float lam, float lam_init, bf16* ocat) {
    PHASE_ENTER(F);
    const int gw = F.vcu * NWAVES + F.wave, NGW = F.G * NWAVES;
    for (int it = gw; it < NB * 4 * (SEQ / 64); it += NGW) {
        const int qb = (SEQ / 64 - 1) - it / (NB * 4), bh = it % (NB * 4), b = bh >> 2, h = bh & 3;
        const int q = qb * 64 + F.lane; const size_t tok = (size_t)b * SEQ + q;
        const float slope2 = exp2f(-2.f * (float)(h + 1)) * LOG2E;
        for (int sub = 0; sub < 4; ++sub) {
            const int c = sub >> 1, vh = sub & 1;
            float qv[64], acc[64];
            { const u32x4* qp = (const u32x4*)(proj + tok * DIN + C_DQ + h * 128 + c * 64);
#pragma unroll
              for (int i = 0; i < 8; ++i) { const u32x4 w = qp[i];
#pragma unroll
                  for (int k = 0; k < 4; ++k) { qv[8 * i + 2 * k] = bflo(w[k]); qv[8 * i + 2 * k + 1] = bfhi(w[k]); } } }
#pragma unroll
            for (int i = 0; i < 64; ++i) acc[i] = 0.f;
            float mx = -INFINITY, l = 0.f;
            const int kend = qb * 64 + 63;
            for (int kk = 0; kk <= kend; ++kk) {
                const bf16* kr = proj + ((size_t)b * SEQ + kk) * DIN;
                const u32x4* kp = (const u32x4*)(kr + C_DK + h * 128 + c * 64);
                float s = 0.f;
#pragma unroll
                for (int i = 0; i < 8; ++i) { const u32x4 w = kp[i];
#pragma unroll
                    for (int k = 0; k < 4; ++k) { s += qv[8 * i + 2 * k] * bflo(w[k]); s += qv[8 * i + 2 * k + 1] * bfhi(w[k]); } }
                if (kk <= q) {
                    const float lg = s - slope2 * (float)(q - kk);
                    const float mn = fmaxf(mx, lg), al = exp2f(mx - mn), p = exp2f(lg - mn);
                    l = l * al + p; mx = mn;
                    const u32x4* vp = (const u32x4*)(kr + C_DV + h * 128 + vh * 64);
#pragma unroll
                    for (int i = 0; i < 8; ++i) { const u32x4 w = vp[i];
#pragma unroll
                        for (int k = 0; k < 4; ++k) { acc[8 * i + 2 * k] = acc[8 * i + 2 * k] * al + p * bflo(w[k]); acc[8 * i + 2 * k + 1] = acc[8 * i + 2 * k + 1] * al + p * bfhi(w[k]); } }
                }
            }
            const float rl = 1.f / l;
            u32x4* tp = (u32x4*)(tmp + ((tok * 4 + h) * 2 + c) * 128 + vh * 64);
#pragma unroll
            for (int i = 0; i < 8; ++i) { u32x4 w;
#pragma unroll
                for (int k = 0; k < 4; ++k) w[k] = pk2(acc[8 * i + 2 * k] * rl, acc[8 * i + 2 * k + 1] * rl);
                tp[i] = w; }
        }
        VM_WAIT();
        { const u32x4* t0 = (const u32x4*)(tmp + ((tok * 4 + h) * 2 + 0) * 128); const u32x4* t1 = (const u32x4*)(tmp + ((tok * 4 + h) * 2 + 1) * 128);
          float o[128]; float ss = 0.f;
#pragma unroll
          for (int i = 0; i < 16; ++i) { const u32x4 a = t0[i], bq = t1[i];
#pragma unroll
              for (int k = 0; k < 4; ++k) { o[8 * i + 2 * k] = bflo(a[k]) - lam * bflo(bq[k]); o[8 * i + 2 * k + 1] = bfhi(a[k]) - lam * bfhi(bq[k]); ss += o[8 * i + 2 * k] * o[8 * i + 2 * k] + o[8 * i + 2 * k + 1] * o[8 * i + 2 * k + 1]; } }
          const float sc = (1.f - lam_init) / sqrtf(ss * (1.f / 128.f) + EPS);
          u32x4* op = (u32x4*)(ocat + tok * D + 512 + h * 128);
#pragma unroll
          for (int i = 0; i < 16; ++i) { u32x4 w;
#pragma unroll
              for (int k = 0; k < 4; ++k) w[k] = pk2(o[8 * i + 2 * k] * sc * subg[8 * i + 2 * k], o[8 * i + 2 * k + 1] * sc * subg[8 * i + 2 * k + 1]);
              op[i] = w; } }
    }
}


__device__ __forceinline__ void phase_attn_prep(Frame& F, bf16* proj, const float* gq, const float* gk, unsigned char* kimg, unsigned char* vimg) {
    PHASE_ENTER(F);
    const int gw = F.vcu * NWAVES + F.wave, NGW = F.G * NWAVES;
    const int d0 = (F.lane & 7) * 8;
    float gqv[8], gkv[8];
#pragma unroll
    for (int i = 0; i < 8; ++i) { gqv[i] = gq[d0 + i] * (0.125f * LOG2E); gkv[i] = gk[d0 + i]; }
    u32x4 nx[2];
    if (gw < M) { nx[0] = *((const u32x4*)(proj + (size_t)gw * DIN + C_DQ) + F.lane); nx[1] = *((const u32x4*)(proj + (size_t)gw * DIN + C_DK) + F.lane); }
    for (int m = gw; m < M; m += NGW) {
        const int b = m / SEQ, pos = m % SEQ;
        const u32x4 cur0 = nx[0], cur1 = nx[1];
        if (m + NGW < M) { nx[0] = *((const u32x4*)(proj + (size_t)(m + NGW) * DIN + C_DQ) + F.lane); nx[1] = *((const u32x4*)(proj + (size_t)(m + NGW) * DIN + C_DK) + F.lane); }
#pragma unroll
        for (int which = 0; which < 2; ++which) {
            u32x4* p = (u32x4*)(proj + (size_t)m * DIN + (which ? C_DK : C_DQ)) + F.lane;
            const u32x4 w = which ? cur1 : cur0; float v[8];
#pragma unroll
            for (int q = 0; q < 4; ++q) { v[2 * q] = bflo(w[q]); v[2 * q + 1] = bfhi(w[q]); }
            float sq = 0.f;
#pragma unroll
            for (int i = 0; i < 8; ++i) sq += v[i] * v[i];
            sq += __shfl_xor(sq, 1); sq += __shfl_xor(sq, 2); sq += __shfl_xor(sq, 4);
            const float rstd = __builtin_amdgcn_rsqf(sq * (1.f / 64.f) + EPS);
            u32x4 o;
#pragma unroll
            for (int q = 0; q < 4; ++q) o[q] = pk2(v[2 * q] * rstd * (which ? gkv[2 * q] : gqv[2 * q]), v[2 * q + 1] * rstd * (which ? gkv[2 * q + 1] : gqv[2 * q + 1]));
            if (which == 0) *p = o;
            else { const int hc = F.lane >> 3;
                const int tile = pos >> 6, kvl = pos & 63, half = kvl >> 5, ks = d0 >> 4, hb = (d0 >> 3) & 1, l = (kvl & 31) + 32 * hb;
                *(u32x4*)(kimg + ((size_t)((b * 8 + hc) * 64 + tile)) * 8192 + (half * 4 + ks) * 1024 + l * 16) = o; }
        }
    }
    LAS unsigned char* vs = F.lds + F.wave * 16384;
    for (int it = gw; it < NB * 4 * 64; it += NGW) {
        const int bh = it >> 6, tile = it & 63, b = bh >> 2, h = bh & 3;
        const bf16* src = proj + (size_t)(b * SEQ + tile * 64) * DIN + C_DV + h * 128;
#pragma unroll
        for (int i = 0; i < 16; ++i) { const int row = 4 * i + (F.lane >> 4), ch = F.lane & 15;
            *(LAS u32x4*)(vs + row * 256 + ch * 16) = *(const u32x4*)(src + (size_t)row * DIN + ch * 8); }
        LDS_WAIT(); asm volatile("" ::: "memory");
        unsigned char* dst = vimg + (size_t)it * 16384 + F.lane * 16;
        const int dl = F.lane & 31, hh = F.lane >> 5;
#pragma unroll
        for (int f = 0; f < 16; ++f) { const int db = f >> 2, t2 = (f >> 1) & 1, sp = f & 1;
            const LAS bf16* col = (const LAS bf16*)vs + (32 * t2 + 16 * sp + 4 * hh) * 128 + 32 * db + dl;
            u32x4 o;
            o.x = (unsigned)col[0 * 128] | ((unsigned)col[1 * 128] << 16); o.y = (unsigned)col[2 * 128] | ((unsigned)col[3 * 128] << 16);
            o.z = (unsigned)col[8 * 128] | ((unsigned)col[9 * 128] << 16); o.w = (unsigned)col[10 * 128] | ((unsigned)col[11 * 128] << 16);
            *(u32x4*)(dst + f * 1024) = o; }
        LDS_WAIT(); asm volatile("" ::: "memory");
    }
}

typedef float f32x16 __attribute__((ext_vector_type(16)));
__device__ __forceinline__ bf16x8 pack8(float a0, float a1, float a2, float a3, float a4, float a5, float a6, float a7) {
    u32x4 w; w.x = pg8::cvt_pk_bf16(a0, a1); w.y = pg8::cvt_pk_bf16(a2, a3); w.z = pg8::cvt_pk_bf16(a4, a5); w.w = pg8::cvt_pk_bf16(a6, a7); return __builtin_bit_cast(bf16x8, w); }
__device__ __forceinline__ void phase_attn(Frame& F, const bf16* proj, const unsigned char* kimg, const unsigned char* vimg, const float* subg, const float* misc, const int* order, gu32* ticket, bf16* ocat) {
    PHASE_ENTER(F);
    const int lane = F.lane, wave = F.wave, hi = lane >> 5, l31 = lane & 31, cm = wave >> 2, wq = wave & 3;
    constexpr int VR0 = 65536;
#define ATT_LDSRD(dst, vaddr, off) asm volatile("ds_read_b128 %0, %1 offset:%2" : "=v"(dst) : "v"(vaddr), "i"(off))
#define ATT_LDSWAIT(dst, n) asm volatile("s_waitcnt lgkmcnt(%1)" : "+v"(dst) : "i"(n))
#define ATT_DMA(src, dstoff) __builtin_amdgcn_global_load_lds((const unsigned*)(src), (LAS unsigned*)(F.lds + (dstoff)), 16, 0, 0)
#define ATT_DMA_K(t, slot) do { const size_t o_ = (size_t)(t) * 8192 + wave * 1024 + lane * 16; ATT_DMA(kb0 + o_, (slot) * 16384 + wave * 1024); ATT_DMA(kb1 + o_, (slot) * 16384 + 8192 + wave * 1024); } while (0)
#define ATT_DMA_V(t, slot) do { const size_t o_ = (size_t)(t) * 16384 + wave * 1024 + lane * 16; ATT_DMA(vb + o_, VR0 + (slot) * 16384 + wave * 1024); ATT_DMA(vb + o_ + 8192, VR0 + (slot) * 16384 + 8192 + wave * 1024); } while (0)
    const float lam = misc[0], lam_init = misc[1], B2 = misc[2];
    if (F.tid == 0) F.LC[76] = __hip_atomic_fetch_add(ticket, 1u, RLX_AGENT);
    __syncthreads();
    for (;;) {
        const int tk = (int)F.LC[76]; if (tk >= 1024) break;
        unsigned tk_next = 0u; if (F.tid == 0) tk_next = __hip_atomic_fetch_add(ticket, 1u, RLX_AGENT);
        const int v = order[tk], bh = v >> 5, qb = v & 31, b = bh >> 2, h = bh & 3;
        const int q0 = qb * 128, NT = 2 * qb + 2, qpos = q0 + 32 * wq + l31;
        int TS = (q0 - (int)misc[3 + h]) >> 6; if (TS < 0) TS = 0;
        const unsigned char* kb0 = kimg + (size_t)((bh * 2 + 0) * 64) * 8192; const unsigned char* kb1 = kimg + (size_t)((bh * 2 + 1) * 64) * 8192;
        const unsigned char* vb = vimg + (size_t)(bh * 64) * 16384;
        bf16x8 qf[4];
        { const bf16* qp = proj + (size_t)(b * SEQ + qpos) * DIN + C_DQ + h * 128 + cm * 64 + 8 * hi;
#pragma unroll
          for (int ks = 0; ks < 4; ++ks) qf[ks] = *(const bf16x8*)(qp + 16 * ks); }
        const float slope2 = exp2f(-2.f * (float)(h + 1)) * LOG2E;
        const float cb = -slope2 * (float)qpos - B2 + slope2 * (float)(4 * hi);
        f32x16 O[4];
#pragma unroll
        for (int db = 0; db < 4; ++db)
#pragma unroll
            for (int r = 0; r < 16; ++r) O[db][r] = 0.f;
        float lsum = 0.f;
        f32x16 pC0, pC1, pN0, pN1;
#define ATT_QK(P0, P1, t, slot) do { const float base_ = cb + slope2 * (float)(64 * (t)); \
            _Pragma("unroll") for (int r = 0; r < 16; ++r) { P0[r] = fmaf(slope2, (float)((r & 3) + 8 * (r >> 2)), base_); P1[r] = fmaf(slope2, (float)(32 + (r & 3) + 8 * (r >> 2)), base_); } \
            if ((t) >= NT - 2) { _Pragma("unroll") for (int r = 0; r < 16; ++r) { const int kv_ = 64 * (t) + (r & 3) + 8 * (r >> 2) + 4 * hi; if (kv_ > qpos) P0[r] = -INFINITY; if (kv_ + 32 > qpos) P1[r] = -INFINITY; } } \
            const unsigned ka_ = (unsigned)(uintptr_t)(F.lds + (slot) * 16384 + cm * 8192 + lane * 16); bf16x8 kq_[4]; \
            ATT_LDSRD(kq_[0], ka_, 0); ATT_LDSRD(kq_[1], ka_, 4096); ATT_LDSRD(kq_[2], ka_, 1024); ATT_LDSRD(kq_[3], ka_, 5120); \
            ATT_LDSWAIT(kq_[0], 3); P0 = __builtin_amdgcn_mfma_f32_32x32x16_bf16(kq_[0], qf[0], P0, 0, 0, 0); ATT_LDSRD(kq_[0], ka_, 2048); \
            ATT_LDSWAIT(kq_[1], 3); P1 = __builtin_amdgcn_mfma_f32_32x32x16_bf16(kq_[1], qf[0], P1, 0, 0, 0); ATT_LDSRD(kq_[1], ka_, 6144); \
            ATT_LDSWAIT(kq_[2], 3); P0 = __builtin_amdgcn_mfma_f32_32x32x16_bf16(kq_[2], qf[1], P0, 0, 0, 0); ATT_LDSRD(kq_[2], ka_, 3072); \
            ATT_LDSWAIT(kq_[3], 3); P1 = __builtin_amdgcn_mfma_f32_32x32x16_bf16(kq_[3], qf[1], P1, 0, 0, 0); ATT_LDSRD(kq_[3], ka_, 7168); \
            ATT_LDSWAIT(kq_[0], 3); P0 = __builtin_amdgcn_mfma_f32_32x32x16_bf16(kq_[0], qf[2], P0, 0, 0, 0); \
            ATT_LDSWAIT(kq_[1], 2); P1 = __builtin_amdgcn_mfma_f32_32x32x16_bf16(kq_[1], qf[2], P1, 0, 0, 0); \
            ATT_LDSWAIT(kq_[2], 1); P0 = __builtin_amdgcn_mfma_f32_32x32x16_bf16(kq_[2], qf[3], P0, 0, 0, 0); \
            ATT_LDSWAIT(kq_[3], 0); P1 = __builtin_amdgcn_mfma_f32_32x32x16_bf16(kq_[3], qf[3], P1, 0, 0, 0); } while (0)
#define ATT_CL(x) ((x) < NT ? (x) : NT - 1)
        ATT_DMA_K(TS, 0); ATT_DMA_K(ATT_CL(TS + 1), 1); ATT_DMA_V(TS, 0); ATT_DMA_K(ATT_CL(TS + 2), 2); ATT_DMA_V(ATT_CL(TS + 1), 1); ATT_DMA_K(ATT_CL(TS + 3), 3); ATT_DMA_V(ATT_CL(TS + 2), 2);
        asm volatile("s_waitcnt vmcnt(12)" ::: "memory"); __builtin_amdgcn_s_barrier(); asm volatile("" ::: "memory");
        ATT_QK(pC0, pC1, TS, 0);
        for (int t = TS; t < NT; ++t) {
            const int ks1 = (t + 1 - TS) & 3, ks0 = (t - TS) & 3, vs0 = ks0, vs3 = (t + 3 - TS) & 3;
            asm volatile("s_waitcnt vmcnt(8)" ::: "memory"); __builtin_amdgcn_s_barrier(); asm volatile("" ::: "memory");
            { ATT_DMA_K(ATT_CL(t + 4), ks0); ATT_DMA_V(ATT_CL(t + 3), vs3); }
            if (cm == 0) { if (t + 1 < NT) ATT_QK(pN0, pN1, t + 1, ks1); }
            bf16x8 pk[2][2];
            { float sa = 0.f, sb = 0.f;
#pragma unroll
              for (int r = 0; r < 16; ++r) { pC0[r] = __builtin_amdgcn_exp2f(pC0[r]); pC1[r] = __builtin_amdgcn_exp2f(pC1[r]); sa += pC0[r]; sb += pC1[r]; }
              lsum += sa + sb;
              pk[0][0] = pack8(pC0[0], pC0[1], pC0[2], pC0[3], pC0[4], pC0[5], pC0[6], pC0[7]); pk[0][1] = pack8(pC0[8], pC0[9], pC0[10], pC0[11], pC0[12], pC0[13], pC0[14], pC0[15]);
              pk[1][0] = pack8(pC1[0], pC1[1], pC1[2], pC1[3], pC1[4], pC1[5], pC1[6], pC1[7]); pk[1][1] = pack8(pC1[8], pC1[9], pC1[10], pC1[11], pC1[12], pC1[13], pC1[14], pC1[15]); }
            { const unsigned va_ = (unsigned)(uintptr_t)(F.lds + VR0 + vs0 * 16384 + lane * 16);
              bf16x8 vfr[4];
              ATT_LDSRD(vfr[0], va_, 0); ATT_LDSRD(vfr[1], va_, 1024); ATT_LDSRD(vfr[2], va_, 2048); ATT_LDSRD(vfr[3], va_, 3072);
#define ATT_PV1(i, nwait) do { ATT_LDSWAIT(vfr[(i) & 3], nwait); O[(i) >> 2] = __builtin_amdgcn_mfma_f32_32x32x16_bf16(vfr[(i) & 3], pk[((i) >> 1) & 1][(i) & 1], O[(i) >> 2], 0, 0, 0); \
                  if ((i) + 4 < 16) ATT_LDSRD(vfr[(i) & 3], va_, ((i) + 4) * 1024); } while (0)
              ATT_PV1(0, 3); ATT_PV1(1, 3); ATT_PV1(2, 3); ATT_PV1(3, 3); ATT_PV1(4, 3); ATT_PV1(5, 3); ATT_PV1(6, 3); ATT_PV1(7, 3);
              ATT_PV1(8, 3); ATT_PV1(9, 3); ATT_PV1(10, 3); ATT_PV1(11, 3); ATT_PV1(12, 3); ATT_PV1(13, 2); ATT_PV1(14, 1); ATT_PV1(15, 0);
#undef ATT_PV1
            }
            if (cm == 1) { if (t + 1 < NT) ATT_QK(pN0, pN1, t + 1, ks1); }
            pC0 = pN0; pC1 = pN1;
        }
        lsum += __shfl_xor(lsum, 32);
        const float rl = 1.f / lsum;
        asm volatile("s_waitcnt vmcnt(0) lgkmcnt(0)" ::: "memory"); __builtin_amdgcn_s_barrier(); asm volatile("" ::: "memory");
        LAS float* comb = (LAS float*)F.lds + wq * 4096 + lane;
        if (cm == 1) {
#pragma unroll
            for (int db = 0; db < 4; ++db)
#pragma unroll
                for (int r = 0; r < 16; ++r) comb[(db * 16 + r) * 64] = O[db][r] * rl;
        }
        asm volatile("s_waitcnt lgkmcnt(0)" ::: "memory"); __builtin_amdgcn_s_barrier(); asm volatile("" ::: "memory");
        if (cm == 0) {
            float ss = 0.f;
#pragma unroll
            for (int db = 0; db < 4; ++db)
#pragma unroll
                for (int r = 0; r < 16; ++r) { const float o = O[db][r] * rl - lam * comb[(db * 16 + r) * 64]; O[db][r] = o; ss += o * o; }
            ss += __shfl_xor(ss, 32);
            const float sc = (1.f - lam_init) / sqrtf(ss * (1.f / 128.f) + EPS);
            bf16* op = ocat + (size_t)(b * SEQ + qpos) * D + 512 + h * 128 + 4 * hi;
#pragma unroll
            for (int db = 0; db < 4; ++db)
#pragma unroll
                for (int g = 0; g < 4; ++g) { const f32x4 sg = *(const f32x4*)(subg + 32 * db + 8 * g + 4 * hi);
                    u32x2 w; w.x = pk2(O[db][4 * g] * sc * sg[0], O[db][4 * g + 1] * sc * sg[1]); w.y = pk2(O[db][4 * g + 2] * sc * sg[2], O[db][4 * g + 3] * sc * sg[3]);
                    *(u32x2*)(op + 32 * db + 8 * g) = w; }
        }
        if (F.tid == 0) F.LC[76] = tk_next;
        asm volatile("s_waitcnt lgkmcnt(0)" ::: "memory"); __builtin_amdgcn_s_barrier(); asm volatile("" ::: "memory");
    }
#undef ATT_DMA
#undef ATT_CL
#undef ATT_LDSRD
#undef ATT_LDSWAIT
#undef ATT_DMA_K
#undef ATT_DMA_V
#undef ATT_QK
}


template <bool FULL>
__device__ __forceinline__ void phase_hgrn(Frame& F, const bf16* proj, const float* lbv, const float* gn, float* Limg, float* Dtot, bf16* ocat) {
    PHASE_ENTER(F);
    const int lane = F.lane, wave = F.wave, hi = lane >> 5, l31 = lane & 31, jb = wave & 3, tb = wave >> 2;
    const int ip = F.tid & 63, tq = wave;
    LAS unsigned char* Qp = F.lds;
    LAS unsigned char* Kp = F.lds + 17408;
    LAS unsigned char* KT = F.lds + 34816;
    LAS unsigned char* VT = F.lds + 53248;
    LAS float* GT = (LAS float*)(F.lds + 71680);
    LAS float* D1 = (LAS float*)(F.lds + 75776);
    LAS float* D2 = D1 + 128;
    LAS unsigned char* AT = F.lds + 76800;
    LAS float* SS = (LAS float*)(F.lds + 82944);
    for (int u = F.bx; u < NB * 4 * 8; u += F.G) {
        const int bh = u >> 3, seg = u & 7, b = bh >> 2, h = bh & 3;
        if (!FULL && seg == 7) continue;
        f32x16 S[4];
#pragma unroll
        for (int ib = 0; ib < 4; ++ib)
#pragma unroll
            for (int r = 0; r < 16; ++r) S[ib][r] = 0.f;
        if (FULL) {
            for (int g = 0; g < seg; ++g) { const int up = bh * 8 + g;
#pragma unroll
                for (int ib = 0; ib < 4; ++ib) { const float* lp = Limg + (size_t)up * 16384 + ((jb * 4 + ib) * 64 + lane) * 16; const float* dp = Dtot + up * 128 + 32 * ib + 4 * hi;
#pragma unroll
                    for (int q = 0; q < 4; ++q) { const f32x4 lv = *(const f32x4*)(lp + 4 * q), dv = *(const f32x4*)(dp + 8 * q);
#pragma unroll
                        for (int c = 0; c < 4; ++c) S[ib][4 * q + c] = S[ib][4 * q + c] * dv[c] + lv[c]; } } }
        }
        float dsum0 = 0.f, dsum1 = 0.f;
        const float lb0 = lbv[h * 128 + 2 * ip], lb1 = lbv[h * 128 + 2 * ip + 1];
        unsigned zz[8], vv[8], qq[8];
#define HG_LOAD_RAW(chn) do { const bf16* pr_ = proj + ((size_t)b * SEQ + seg * 512 + (chn) * 64 + 8 * tq) * DIN + h * 128 + 2 * ip; \
            _Pragma("unroll") for (int rr = 0; rr < 8; ++rr) { zz[rr] = *(const unsigned*)(pr_ + (size_t)rr * DIN + C_HF); vv[rr] = *(const unsigned*)(pr_ + (size_t)rr * DIN + C_HI); if (FULL) qq[rr] = *(const unsigned*)(pr_ + (size_t)rr * DIN + C_HQ); } } while (0)
        HG_LOAD_RAW(0);
        for (int ch = 0; ch < 8; ++ch) {
            const size_t tok0 = (size_t)b * SEQ + seg * 512 + ch * 64;
            u32x2 gate[4];
            if (FULL) { const bf16* gp = proj + (tok0 + 32 * tb + l31) * DIN + C_HG + h * 128 + 32 * jb + 4 * hi;
#pragma unroll
                for (int g = 0; g < 4; ++g) gate[g] = *(const u32x2*)(gp + 8 * g); }
            float cs0[8], cs1[8], kk0[8], kk1[8];
            { float c0 = 0.f, c1 = 0.f;
#pragma unroll
              for (int rr = 0; rr < 8; ++rr) { const float z0 = bflo(zz[rr]), z1 = bfhi(zz[rr]);
                  const float e0 = __expf(-z0), e1 = __expf(-z1), s0 = __builtin_amdgcn_rcpf(1.f + e0), s1 = __builtin_amdgcn_rcpf(1.f + e1);
                  c0 += __builtin_amdgcn_logf(lb0 + (1.f - lb0) * s0); c1 += __builtin_amdgcn_logf(lb1 + (1.f - lb1) * s1); cs0[rr] = c0; cs1[rr] = c1;
                  kk0[rr] = (1.f - lb0) * e0 * s0; kk1[rr] = (1.f - lb1) * e1 * s1; }
              GT[tq * 128 + 2 * ip] = c0; GT[tq * 128 + 2 * ip + 1] = c1; }
            __syncthreads();
            float pre0 = 0.f, pre1 = 0.f, rho0 = 0.f, rho1 = 0.f, tot0 = 0.f, tot1 = 0.f;
#pragma unroll
            for (int g = 0; g < 8; ++g) { const f32x2 gt = *(const LAS f32x2*)(GT + g * 128 + 2 * ip);
                if (g < tq) { pre0 += gt.x; pre1 += gt.y; } if (g < 4) { rho0 += gt.x; rho1 += gt.y; } tot0 += gt.x; tot1 += gt.y; }
            { u32x4 kt0, kt1, vt0, vt1;
#pragma unroll
              for (int rr = 0; rr < 8; rr += 2) {
                  float k0[2], k1[2];
#pragma unroll
                  for (int e = 0; e < 2; ++e) { const int r2 = rr + e; const float b0 = pre0 + cs0[r2], b1 = pre1 + cs1[r2];
                      k0[e] = kk0[r2] * __builtin_amdgcn_exp2f(rho0 - b0); k1[e] = kk1[r2] * __builtin_amdgcn_exp2f(rho1 - b1);
                      *(LAS unsigned*)(Kp + (8 * tq + r2) * 272 + 4 * ip) = pk2(k0[e], k1[e]);
                      if (FULL) { const float q0 = bflo(qq[r2]) * __builtin_amdgcn_exp2f(b0 - rho0), q1 = bfhi(qq[r2]) * __builtin_amdgcn_exp2f(b1 - rho1);
                          *(LAS unsigned*)(Qp + (8 * tq + r2) * 272 + 4 * ip) = pk2(q0, q1); } }
                  kt0[rr >> 1] = pk2(k0[0], k0[1]); kt1[rr >> 1] = pk2(k1[0], k1[1]);
                  vt0[rr >> 1] = (vv[rr] & 0xffffu) | (vv[rr + 1] << 16); vt1[rr >> 1] = (vv[rr] >> 16) | (vv[rr + 1] & 0xffff0000u); }
              *(LAS u32x4*)(KT + (2 * ip) * 144 + 16 * tq) = kt0; *(LAS u32x4*)(KT + (2 * ip + 1) * 144 + 16 * tq) = kt1;
              *(LAS u32x4*)(VT + (2 * ip) * 144 + 16 * tq) = vt0; *(LAS u32x4*)(VT + (2 * ip + 1) * 144 + 16 * tq) = vt1; }
            if (tq == 0) { D1[2 * ip] = __builtin_amdgcn_exp2f(rho0); D1[2 * ip + 1] = __builtin_amdgcn_exp2f(rho1); D2[2 * ip] = __builtin_amdgcn_exp2f(tot0 - rho0); D2[2 * ip + 1] = __builtin_amdgcn_exp2f(tot1 - rho1); }
            dsum0 += tot0; dsum1 += tot1;
            __syncthreads();
            if (ch < 7) HG_LOAD_RAW(ch + 1);
#pragma unroll
            for (int ib = 0; ib < 4; ++ib)
#pragma unroll
                for (int q = 0; q < 4; ++q) { const f32x4 dv = *(const LAS f32x4*)(D1 + 32 * ib + 8 * q + 4 * hi);
#pragma unroll
                    for (int c = 0; c < 4; ++c) S[ib][4 * q + c] *= dv[c]; }
            f32x16 Ot;
            if (FULL) {
#pragma unroll
                for (int r = 0; r < 16; ++r) Ot[r] = 0.f;
#pragma unroll
                for (int ib = 0; ib < 4; ++ib)
#pragma unroll
                    for (int sp = 0; sp < 2; ++sp) { const bf16x8 a = pack8(S[ib][8 * sp], S[ib][8 * sp + 1], S[ib][8 * sp + 2], S[ib][8 * sp + 3], S[ib][8 * sp + 4], S[ib][8 * sp + 5], S[ib][8 * sp + 6], S[ib][8 * sp + 7]);
                        const LAS unsigned char* qp = Qp + (32 * tb + l31) * 272 + (32 * ib + 16 * sp + 4 * hi) * 2;
                        const u32x2 lo = *(const LAS u32x2*)qp, hi2 = *(const LAS u32x2*)(qp + 16);
                        const u32x4 bw = {lo.x, lo.y, hi2.x, hi2.y};
                        Ot = __builtin_amdgcn_mfma_f32_32x32x16_bf16(a, __builtin_bit_cast(bf16x8, bw), Ot, 0, 0, 0); }
                for (int sb = 0; sb <= tb; ++sb) {
                    f32x16 P;
#pragma unroll
                    for (int r = 0; r < 16; ++r) P[r] = 0.f;
#pragma unroll
                    for (int ks = 0; ks < 8; ++ks) { const bf16x8 a = *(const LAS bf16x8*)(Kp + (32 * sb + l31) * 272 + (16 * ks + 8 * hi) * 2), bq = *(const LAS bf16x8*)(Qp + (32 * tb + l31) * 272 + (16 * ks + 8 * hi) * 2);
                        P = __builtin_amdgcn_mfma_f32_32x32x16_bf16(a, bq, P, 0, 0, 0); }
                    if (sb == tb) {
#pragma unroll
                        for (int r = 0; r < 16; ++r) if ((r & 3) + 8 * (r >> 2) + 4 * hi > l31) P[r] = 0.f; }
#pragma unroll
                    for (int sp = 0; sp < 2; ++sp) { const LAS unsigned char* vp = VT + (32 * jb + l31) * 144 + (32 * sb + 16 * sp + 4 * hi) * 2;
                        const u32x2 lo = *(const LAS u32x2*)vp, hi2 = *(const LAS u32x2*)(vp + 16);
                        const u32x4 aw = {lo.x, lo.y, hi2.x, hi2.y};
                        const bf16x8 bq = pack8(P[8 * sp], P[8 * sp + 1], P[8 * sp + 2], P[8 * sp + 3], P[8 * sp + 4], P[8 * sp + 5], P[8 * sp + 6], P[8 * sp + 7]);
                        Ot = __builtin_amdgcn_mfma_f32_32x32x16_bf16(__builtin_bit_cast(bf16x8, aw), bq, Ot, 0, 0, 0); } }
            }
#pragma unroll
            for (int ks = 0; ks < 4; ++ks) { const bf16x8 bv = *(const LAS bf16x8*)(VT + (32 * jb + l31) * 144 + (16 * ks + 8 * hi) * 2);
#pragma unroll
                for (int ib = 0; ib < 4; ++ib) { const bf16x8 a = *(const LAS bf16x8*)(KT + (32 * ib + l31) * 144 + (16 * ks + 8 * hi) * 2);
                    S[ib] = __builtin_amdgcn_mfma_f32_32x32x16_bf16(a, bv, S[ib], 0, 0, 0); } }
#pragma unroll
            for (int ib = 0; ib < 4; ++ib)
#pragma unroll
                for (int q = 0; q < 4; ++q) { const f32x4 dv = *(const LAS f32x4*)(D2 + 32 * ib + 8 * q + 4 * hi);
#pragma unroll
                    for (int c = 0; c < 4; ++c) S[ib][4 * q + c] *= dv[c]; }
            if (FULL) {
                float ss = 0.f;
#pragma unroll
                for (int r = 0; r < 16; ++r) ss += Ot[r] * Ot[r];
                ss += __shfl_xor(ss, 32);
                if (hi == 0) SS[jb * 64 + 32 * tb + l31] = ss;
                __syncthreads();
                const int t = 32 * tb + l31;
                const float rstd = 1.f / sqrtf((SS[t] + SS[64 + t] + SS[128 + t] + SS[192 + t]) * (1.f / 128.f) + EPS);
                bf16* op = ocat + (tok0 + t) * D + h * 128 + 32 * jb + 4 * hi;
#pragma unroll
                for (int g = 0; g < 4; ++g) { const f32x4 gv = *(const f32x4*)(gn + 32 * jb + 8 * g + 4 * hi);
                    const float g0 = bflo(gate[g].x), g1 = bfhi(gate[g].x), g2 = bflo(gate[g].y), g3 = bfhi(gate[g].y);
                    u32x2 w; w.x = pk2(Ot[4 * g] * rstd * gv[0] * (g0 * sigm(g0)), Ot[4 * g + 1] * rstd * gv[1] * (g1 * sigm(g1)));
                    w.y = pk2(Ot[4 * g + 2] * rstd * gv[2] * (g2 * sigm(g2)), Ot[4 * g + 3] * rstd * gv[3] * (g3 * sigm(g3)));
                    *(u32x2*)(op + 8 * g) = w; }
            }
        }
        if (!FULL) {
            if (tb == 0) {
#pragma unroll
                for (int ib = 0; ib < 4; ++ib) { float* lp = Limg + (size_t)u * 16384 + ((jb * 4 + ib) * 64 + lane) * 16;
#pragma unroll
                    for (int q = 0; q < 4; ++q) *(f32x4*)(lp + 4 * q) = (f32x4){S[ib][4 * q], S[ib][4 * q + 1], S[ib][4 * q + 2], S[ib][4 * q + 3]}; } }
            if (tq == 0) { Dtot[u * 128 + 2 * ip] = __builtin_amdgcn_exp2f(dsum0); Dtot[u * 128 + 2 * ip + 1] = __builtin_amdgcn_exp2f(dsum1); }
        }
        __syncthreads();
    }
#undef HG_LOAD_RAW
}

#ifndef REP_ATTN
#define REP_ATTN 1
#endif
#ifndef REP_HGRN
#define REP_HGRN 1
#endif
#ifndef REP_G1
#define REP_G1 1
#endif
#ifndef REP_MUP
#define REP_MUP 1
#endif
#ifndef REP_F1
#define REP_F1 1
#endif
#ifndef REP_PREP
#define REP_PREP 1
#endif
__global__ void __launch_bounds__(NTHR, 2) mega_fwd(Args args) {
    extern __shared__ __attribute__((aligned(16))) unsigned char lds[];
    Frame F;
    F.lds = (LAS unsigned char*)lds;
    F.LC = (volatile LAS unsigned*)(F.lds + LDSCTL_OFF);
    volatile LAS unsigned* MISC = (volatile LAS unsigned*)(F.lds + MISC_OFF);
    F.tid = threadIdx.x; F.lane = F.tid & 63; F.wave = __builtin_amdgcn_readfirstlane(F.tid >> 6);
    F.G = gridDim.x; { const int bx = blockIdx.x; F.vcu = (F.G % 8 == 0) ? (bx % 8) * (F.G / 8) + bx / 8 : bx; }
    F.ws = args.ws; F.ctl = (gu32*)(args.ws + WS_CTL); F.adaf = (float*)(args.ws + WS_ADA);
    for (int u = F.tid; u < (LDS_BYTES - LDSCTL_OFF) / 4; u += NTHR) ((LAS unsigned*)(F.lds + LDSCTL_OFF))[u] = 0u;
    __syncthreads();
    XcdBarrier bar = xcd_barrier_post((unsigned*)(F.ctl + CW_BAR), MISC + 8);
#define GRID_BAR() xcd_barrier(bar)
    unsigned char* ws = args.ws;
    F.bx = blockIdx.x;
    bf16* Hb = (bf16*)(ws + WS_H); bf16* OC = (bf16*)(ws + WS_OCAT); bf16* PROJ = (bf16*)(ws + WS_PROJ);
    float* xout = args.out; bf16* X16 = (bf16*)(ws + WS_X16);

    phase_prologue(F, args, 0);
    GRID_BAR();

    for (int l = 0; l < DEPTH; ++l) {
        const float* ada_l = F.adaf + AO_ADA + (size_t)l * NB * ADA_N;
        if (l == 0) phase_norm<false, 1, false>(F, args.in[0], args.in[4] + l * D, ada_l, 0, 1, ws + WS_H8, nullptr, F.adaf + AO_RS, nullptr, nullptr, nullptr);
        else phase_norm<false, 1, true>(F, X16, args.in[4] + l * D, ada_l, 0, 1, ws + WS_H8, nullptr, F.adaf + AO_RS, nullptr, nullptr, nullptr);
        GRID_BAR();
        { pg8::Gemm g{(const bf16*)(ws + WS_H8), (const bf16*)(ws + WS_WIN8 + (size_t)l * DIN * D), D / 2}; pg8::StaticOrder S; S.init(M, DIN, F.G, (int)blockIdx.x);
          pg8::EpiBf16<true> E{PROJ, DIN, QW_INV, F.adaf + AO_RS, C_GA / 256}; pg8::ADense AO;
          if (l == 0 && (blockIdx.x & 1)) { phase_prologue(F, args, 1); __syncthreads(); }
          for (int rep = 0; rep < REP_G1; ++rep) pg8::gemm_phase<pg8::EpiBf16<true>, pg8::StaticOrder, pg8::ADense, true, 2>(F.lds, g, S, AO, E);
          if (l == 0 && !(blockIdx.x & 1)) { __syncthreads(); phase_prologue(F, args, 1); } }
        GRID_BAR();
#ifdef NAIVE_ATTN
        phase_qkprep(F, PROJ, args.in[9] + l * 64, args.in[10] + l * 64);
#else
        phase_attn_prep(F, PROJ, args.in[9] + l * 64, args.in[10] + l * 64, ws + WS_KIMG, ws + WS_VIMG);
#endif
#ifndef NAIVE_HGRN
        __syncthreads();
        phase_hgrn<false>(F, PROJ, F.adaf + AO_LB + l * 512, args.in[8] + l * 128, (float*)(ws + WS_HL), (float*)(ws + WS_HD), OC);
#endif
        GRID_BAR();
#ifdef NAIVE_HGRN
        phase_hgrn_naive(F, PROJ, F.adaf + AO_LB + l * 512, args.in[8] + l * 128, OC);
#else
        for (int rep = 0; rep < REP_HGRN; ++rep) phase_hgrn<true>(F, PROJ, F.adaf + AO_LB + l * 512, args.in[8] + l * 128, (float*)(ws + WS_HL), (float*)(ws + WS_HD), OC);
#endif
#ifdef NAIVE_ATTN
        phase_attn_naive(F, PROJ, Hb, args.in[12] + l * 128, F.adaf[AO_MISC + l * 8 + 0], F.adaf[AO_MISC + l * 8 + 1], OC);
#else
        phase_attn(F, PROJ, ws + WS_KIMG, ws + WS_VIMG, args.in[12] + l * 128, F.adaf + AO_MISC + l * 8, (const int*)(F.adaf + AO_ORD) + l * 1024, F.ctl + CW_ATT + 64 * l, OC);
#endif
        GRID_BAR();
        { pg8::Gemm g{OC, (const bf16*)(ws + WS_WPAB) + (size_t)l * D * D, D}; pg8::StaticOrder S; S.init(M, D, F.G, (int)blockIdx.x);
          pg8::EpiMerge E{PROJ, Hb}; pg8::ADense AO;
          pg8::gemm_phase<pg8::EpiMerge, pg8::StaticOrder, pg8::ADense, true>(F.lds, g, S, AO, E); }
        GRID_BAR();
        { pg8::Gemm g{Hb, (const bf16*)(ws + WS_WO) + (size_t)l * D * D, D}; pg8::StaticOrder S; S.init(M, D, F.G, (int)blockIdx.x);
          pg8::ADense AO;
          if (l == 0) { pg8::EpiRes<true> E{args.in[0], X16, ada_l + 2 * D, 1.f}; pg8::gemm_phase<pg8::EpiRes<true>, pg8::StaticOrder, pg8::ADense, true>(F.lds, g, S, AO, E); }
          else {
              if (blockIdx.x & 1) { phase_moe_weights(F, args); __syncthreads(); }
              pg8::EpiRes<false> E{X16, X16, ada_l + 2 * D, 1.f}; pg8::gemm_phase<pg8::EpiRes<false>, pg8::StaticOrder, pg8::ADense, true>(F.lds, g, S, AO, E);
              if (!(blockIdx.x & 1)) { __syncthreads(); phase_moe_weights(F, args); } } }
        GRID_BAR();
        if (l == 0) {
            phase_norm<false, 1, true>(F, X16, args.in[5] + l * D, ada_l, 3, 4, Hb, nullptr, F.adaf + AO_RS, nullptr, nullptr, nullptr);
            GRID_BAR();
            { pg8::Gemm g{Hb, (const bf16*)(ws + WS_W13), D / 2}; pg8::StaticOrder S; S.init(M, 2 * DFF, F.G, (int)blockIdx.x);
              pg8::EpiSwiglu<false, true> E{(void*)(ws + WS_HID), DFF, 0, QW_INV, F.adaf + AO_RS, nullptr}; pg8::ADense AO;
              for (int rep = 0; rep < REP_F1; ++rep) pg8::gemm_phase<pg8::EpiSwiglu<false, true>, pg8::StaticOrder, pg8::ADense, true, 2>(F.lds, g, S, AO, E); }
            GRID_BAR();
            { pg8::Gemm g{(const bf16*)(ws + WS_HID), (const bf16*)(ws + WS_W2), DFF}; pg8::StaticOrder S; S.init(M, D, F.G, (int)blockIdx.x);
              pg8::EpiRes<false> E{X16, X16, ada_l + 5 * D, 1.f}; pg8::ADense AO;
              pg8::gemm_phase<pg8::EpiRes<false>, pg8::StaticOrder, pg8::ADense, true, 0>(F.lds, g, S, AO, E); }
            GRID_BAR();
        } else {
            int* toke = (int*)(ws + WS_TOKE); float* tokw = (float*)(ws + WS_TOKW); int* list = (int*)(ws + WS_LIST); float* wl = (float*)(ws + WS_WL);
#ifndef SKIP_NORMMOE
            phase_norm<true, 1, true>(F, X16, args.in[5] + l * D, ada_l, 3, 4, Hb, nullptr, F.adaf + AO_RS, args.in[19], toke, tokw);
#endif
            GRID_BAR();
            phase_moe_sort(F, toke, tokw, list, wl, F.adaf + AO_RS, (float*)(ws + WS_RSL));
            GRID_BAR();
            const int ndown = (int)F.LC[LC_TOT] * (D / 256), hv = ndown % F.G;
            for (int s = 0; s < 2; ++s) {
              for (int part = 0; part < 2; ++part) {
                if (s == 1 && part == (int)(blockIdx.x & 1)) { pg8::Gemm g{(const bf16*)(ws + WS_HIDM), (const bf16*)(ws + WS_MW2), DFFE / 2}; pg8::MoeOrder S{F.LC, 0, D / 256, F.G, (int)blockIdx.x}; pg8::ADense AO;
                    pg8::EpiMoeDown<false> E{X16, xout, ada_l + 5 * D, list, wl, W8_INV}; pg8::gemm_phase<pg8::EpiMoeDown<false>, pg8::MoeOrder, pg8::ADense, true, 1>(F.lds, g, S, AO, E); }
                if (part == 0) { pg8::Gemm g{Hb, (const bf16*)(ws + WS_MW13), D / 2}; pg8::MoeOrder S{F.LC, s, 2 * DFFE / 256, F.G, (int)blockIdx.x, s == 1 ? hv : 0, 3};
                  pg8::EpiSwiglu<true, true> E{(void*)(ws + WS_HIDM), DFFE, 2 * DFFE / 256, QW_INV, (const float*)(ws + WS_RSL), nullptr}; pg8::AGather AO{list};
                  for (int rep = 0; rep < REP_MUP; ++rep) pg8::gemm_phase<pg8::EpiSwiglu<true, true>, pg8::MoeOrder, pg8::AGather, true, 2>(F.lds, g, S, AO, E); }
              }
                GRID_BAR();
            }
            { pg8::Gemm g{(const bf16*)(ws + WS_HIDM), (const bf16*)(ws + WS_MW2), DFFE / 2}; pg8::MoeOrder S{F.LC, 1, D / 256, F.G, (int)blockIdx.x}; pg8::ADense AO;
              pg8::EpiMoeDown<true> E{X16, xout, ada_l + 5 * D, list, wl, W8_INV}; pg8::gemm_phase<pg8::EpiMoeDown<true>, pg8::MoeOrder, pg8::ADense, true, 1>(F.lds, g, S, AO, E); }
        }
    }
}

extern "C" void kernel_launch(void* const* d_in, const int* in_sizes, int n_in, void* d_out, int out_size, void* d_ws, size_t ws_size, hipStream_t stream) {
    static int grid = 0;
    if (grid == 0) {
        if (n_in != 23 || out_size != M * D || ws_size < WS_END) { fprintf(stderr, "kernel_launch: unexpected problem (n_in %d, out %d, ws %zu)\n", n_in, out_size, ws_size); grid = -1; return; }
        int dev = 0, cus = 0;
        if (hipGetDevice(&dev) != hipSuccess || hipDeviceGetAttribute(&cus, hipDeviceAttributeMultiprocessorCount, dev) != hipSuccess) { grid = -1; return; }
        if (hipFuncSetAttribute((const void*)mega_fwd, hipFuncAttributeMaxDynamicSharedMemorySize, LDS_BYTES) != hipSuccess) { fprintf(stderr, "kernel_launch: hipFuncSetAttribute failed\n"); grid = -1; return; }
        int per_cu = 0;
        if (hipOccupancyMaxActiveBlocksPerMultiprocessor(&per_cu, (const void*)mega_fwd, NTHR, LDS_BYTES) != hipSuccess || per_cu < 1) fprintf(stderr, "kernel_launch: occupancy query says %d\n", per_cu);
        (void)hipGetLastError();
        grid = cus;
    }
    if (grid < 0) return;
    if (hipMemsetAsync((char*)d_ws + WS_CTL, 0, CTL_ZERO_BYTES, stream) != hipSuccess) return;
    Args a{};
    for (int i = 0; i < 23; ++i) a.in[i] = (const float*)d_in[i];
    a.out = (float*)d_out; a.ws = (unsigned char*)d_ws;
    hipLaunchKernelGGL(mega_fwd, dim3(grid), dim3(NTHR), LDS_BYTES, stream, a);
}
```

```cpp
#include <hip/hip_runtime.h>
#include <cstdio>
#include <cstdint>

#define GAS __attribute__((address_space(1)))
#define LAS __attribute__((address_space(3)))
typedef unsigned short bf16;
typedef short bf16x8 __attribute__((ext_vector_type(8)));
typedef float f32x4 __attribute__((ext_vector_type(4)));
typedef float f32x2 __attribute__((ext_vector_type(2)));
typedef unsigned u32x4 __attribute__((ext_vector_type(4)));
typedef unsigned u32x2 __attribute__((ext_vector_type(2)));
typedef GAS unsigned gu32;

constexpr int NB = 8, SEQ = 4096, D = 1024, M = NB * SEQ, DEPTH = 2;
constexpr int DIN = 5632;
constexpr int C_HQ = 0, C_HF = 512, C_HI = 1024, C_HG = 1536, C_DQ = 2048, C_DK = 2560, C_DV = 3072, C_GA = 3584, C_GB = 4608;
constexpr int DFF = 2816, NEXP = 8, DFFE = 3584;
constexpr int ADA_N = 6 * D;
constexpr float EPS = 1e-6f;
constexpr float LOG2E = 1.4426950408889634f;
constexpr int NWAVES = 8, NTHR = 512;
constexpr int MOE_ROWS = 34816;

constexpr size_t MiB = 1u << 20;
constexpr size_t WS_CTL = 0, CTL_ZERO_BYTES = 1 * MiB;
constexpr size_t WS_ADA = 1 * MiB;
constexpr size_t WS_WIN8 = 2 * MiB;
constexpr size_t WS_WPAB = 13 * MiB;
constexpr size_t WS_WO = 17 * MiB;
constexpr size_t WS_W13 = 21 * MiB;
constexpr size_t WS_W2 = 26 * MiB + 512 * 1024;
constexpr size_t WS_H = 50 * MiB;
constexpr size_t WS_KIMG = 50 * MiB;
constexpr size_t WS_VIMG = 82 * MiB;
constexpr size_t WS_H8 = 114 * MiB;
constexpr size_t WS_OCAT = 114 * MiB;
constexpr size_t WS_PROJ = 178 * MiB;
constexpr size_t WS_HID = 178 * MiB;
constexpr size_t WS_MW13 = 178 * MiB;
constexpr size_t WS_MW2 = 234 * MiB;
constexpr size_t WS_HIDM = 262 * MiB;
constexpr size_t WS_HL = 32 * MiB;
constexpr size_t WS_HD = 48 * MiB;
constexpr size_t WS_X16 = 530 * MiB;
constexpr size_t WS_END = 594 * MiB;
constexpr size_t WS_TOKE = WS_OCAT;
constexpr size_t WS_TOKW = WS_OCAT + 1 * MiB;
constexpr size_t WS_LIST = WS_OCAT + 2 * MiB;
constexpr size_t WS_WL = WS_OCAT + 3 * MiB;
constexpr size_t WS_RSL = WS_OCAT + 4 * MiB;
constexpr int AO_ADA = 0, AO_LB = 2 * NB * ADA_N, AO_MISC = AO_LB + 2 * 512, AO_ORD = AO_MISC + 16, AO_RS = AO_ORD + 2048;
constexpr int CW_TMO = 0, CW_CODE = 1, CW_BAR = 4096, CW_MOE = 8192, CW_ATT = 12288;

constexpr int RING_BYTES = 131072, LDSCTL_OFF = 147456, MISC_OFF = LDSCTL_OFF + 320, LDS_BYTES = 163840;
constexpr int LC_CNT = 0, LC_TOFF = 16, LC_TOT = 32, LC_LH = 40, LC_BASE = 56;

#define RLX_AGENT __ATOMIC_RELAXED, __HIP_MEMORY_SCOPE_AGENT
#define LDS_WAIT() asm volatile("s_waitcnt lgkmcnt(0)" ::: "memory")
#define VM_WAIT() asm volatile("s_waitcnt vmcnt(0)" ::: "memory")

__device__ __forceinline__ unsigned f2bf(float f) { unsigned u = __builtin_bit_cast(unsigned, f); return (u + 0x7fffu + ((u >> 16) & 1u)) >> 16; }
__device__ __forceinline__ unsigned pk2(float lo, float hi) { unsigned r; asm("v_cvt_pk_bf16_f32 %0, %1, %2" : "=v"(r) : "v"(lo), "v"(hi)); return r; }
__device__ __forceinline__ float bflo(unsigned w) { return __uint_as_float(w << 16); }
__device__ __forceinline__ float bfhi(unsigned w) { return __uint_as_float(w & 0xffff0000u); }
__device__ __forceinline__ float bf2f(bf16 v) { return __uint_as_float((unsigned)v << 16); }
__device__ __forceinline__ unsigned pk4_fp8(float a, float b, float c, float d) { unsigned w = 0; w = __builtin_amdgcn_cvt_pk_fp8_f32(a, b, w, false); w = __builtin_amdgcn_cvt_pk_fp8_f32(c, d, w, true); return w; }
constexpr float QW_SCALE = 720.f, QW_INV = 1.f / QW_SCALE;
__device__ __forceinline__ unsigned q8(float x) { return (unsigned)(int)rintf(fminf(fmaxf(x, -127.f), 127.f)) & 0xffu; }
__device__ __forceinline__ unsigned pk4_i8(float a, float b, float c, float d) { return q8(a) | (q8(b) << 8) | (q8(c) << 16) | (q8(d) << 24); }
constexpr float W8_SCALE = 64.f, W8_INV = 1.f / 64.f;
__device__ __forceinline__ float sigm(float x) { return __builtin_amdgcn_rcpf(1.f + __builtin_amdgcn_exp2f(-LOG2E * x)); }
typedef float f32x16_ __attribute__((ext_vector_type(16)));
__device__ __forceinline__ void opaque_acc(f32x16_& v) { asm volatile("" : "+v"(v)); }
__device__ __forceinline__ unsigned lds_inc(volatile LAS unsigned* p) { return __hip_atomic_fetch_add((LAS unsigned*)p, 1u, __ATOMIC_RELAXED, __HIP_MEMORY_SCOPE_WORKGROUP); }
__device__ __forceinline__ float wave_sum(float v) {
#pragma unroll
    for (int o = 1; o < 64; o <<= 1) v += __shfl_xor(v, o);
    return v;
}

namespace pg8 {
constexpr int BM = 256, BK = 64, HALF = 128, HTB = HALF * BK * 2, STAGE_BYTES = 8 * HTB, NXCD = 8, WGM = 8;
__host__ __device__ __forceinline__ int lds_byte(int r, int c) { const int st = (r >> 4) * 2 + (c >> 5), rr = r & 15, cc = c & 31, ob = rr * 64 + cc * 2; return st * 1024 + (ob ^ (((ob >> 9) & 1) << 5)); }
__host__ __device__ __forceinline__ void stage_rc(int b, int& R, int& C) { const int st = b / 1024, sb = b % 1024, swz = sb ^ (((sb >> 9) & 1) << 5); R = (st >> 1) * 16 + swz / 64; C = (st & 1) * 32 + (swz % 64) / 2; }
__host__ __device__ __forceinline__ int perm32(int rho) { const int n = rho >> 4, i = rho & 15; return 8 * (i >> 2) + 4 * n + (i & 3); }

struct Unit { int pm, pn, e, nvalid; };
struct Gemm { const bf16* A; const bf16* Bt; int K; };

struct StaticOrder {
    int nM, nN, nwg, G, c, rm0, rm1;
    __device__ void init(int M_, int N_, int G_, int c_, int rm0_ = 0, int rm1_ = 0) { nM = M_ / BM; nN = N_ / BM; nwg = nM * nN; G = G_; c = c_; rm0 = rm0_; rm1 = rm1_; }
    __device__ bool next(int i, Unit& u) const {
        const long L = (long)i * G + c; if (L >= nwg) return false;
        int wgid = (int)L; { const int q = nwg / NXCD, r = nwg % NXCD, xcd = wgid % NXCD, off = wgid / NXCD; wgid = (xcd < r ? xcd * (q + 1) : r * (q + 1) + (xcd - r) * q) + off; }
        const int nig = WGM * nN, gid = wgid / nig, fm = gid * WGM, gsz = (nM - fm) < WGM ? (nM - fm) : WGM;
        const int wi = wgid % nig; if (gsz == WGM) { u.pm = fm + (wi & (WGM - 1)); u.pn = wi / WGM; } else { u.pm = fm + (wi % gsz); u.pn = wi / gsz; }
        u.pn += u.pn < 4 ? rm0 : rm1; u.e = 0; u.nvalid = 256; return true;
    }
};
struct MoeOrder {
    const volatile LAS unsigned* lc; int s, nN, G, c; int hv = 0, skipr = 0;
    __device__ bool next(int i, Unit& u) const {
        const int T0 = (int)lc[LC_TOT], T1 = (int)lc[LC_TOT + 1], T = s == 2 ? T0 + T1 : (s == 0 ? T0 : T1);
        const int nwg = __builtin_amdgcn_readfirstlane(T * nN); long L;
        if (c < hv) { L = (long)(i + skipr) * G + c; if (L >= (long)nwg) return false; }
        else { L = (long)i * G + c;
            if (L >= (long)nwg) { if (hv == 0) return false;
                const int nreg = c < nwg ? (nwg - c + G - 1) / G : 0, m = (c - hv) + (i - nreg) * (G - hv); if (m >= skipr * hv) return false;
                L = (long)(m / hv) * G + (m % hv); } }
        int wgid = (int)L; { const int q = nwg / NXCD, r = nwg % NXCD, xcd = wgid % NXCD, off = wgid / NXCD; wgid = (xcd < r ? xcd * (q + 1) : r * (q + 1) + (xcd - r) * q) + off; }
        const int nig = WGM * nN, gid = wgid / nig, fm = gid * WGM, gsz = (T - fm) < WGM ? (T - fm) : WGM;
        const int wi = wgid % nig; int rt, pnl; if (gsz == WGM) { rt = fm + (wi & (WGM - 1)); pnl = wi / WGM; } else { rt = fm + (wi % gsz); pnl = wi / gsz; } int sl = s;
        if (s == 2) { sl = rt >= T0 ? 1 : 0; rt -= sl * T0; }
        int e = 0;
#pragma unroll
        for (int k = 1; k < NEXP; ++k) if ((int)lc[LC_TOFF + sl * 8 + k] <= rt) e = k;
        const int left = (int)lc[LC_CNT + sl * 8 + e] - (rt - (int)lc[LC_TOFF + sl * 8 + e]) * 256;
        u.pm = __builtin_amdgcn_readfirstlane(sl * (MOE_ROWS / 256) + rt); u.pn = __builtin_amdgcn_readfirstlane(e * nN + pnl); u.e = __builtin_amdgcn_readfirstlane(e);
        u.nvalid = __builtin_amdgcn_readfirstlane(left < 256 ? left : 256); return true;
    }
};
struct ADense { static constexpr bool GATHER = false; __device__ __forceinline__ void get(const Unit&, int, int, unsigned (&)[2][2]) const {}
    __device__ __forceinline__ void rows(const Unit&, int, int (&)[2][2]) const {} __device__ __forceinline__ void offs(const int (&)[2][2], int, int, unsigned (&)[2][2]) const {} };
struct AGather { static constexpr bool GATHER = true; const int* list;
    __device__ __forceinline__ void rows(const Unit& u, int tid, int (&row)[2][2]) const {
#pragma unroll
        for (int i = 0; i < 2; ++i) { int R, C; stage_rc(tid * 16 + i * 8192, R, C);
#pragma unroll
            for (int h = 0; h < 2; ++h) row[h][i] = list[u.pm * BM + h * HALF + R]; } }
    __device__ __forceinline__ void offs(const int (&row)[2][2], int tid, int K, unsigned (&off)[2][2]) const {
#pragma unroll
        for (int i = 0; i < 2; ++i) { int R, C; stage_rc(tid * 16 + i * 8192, R, C);
#pragma unroll
            for (int h = 0; h < 2; ++h) off[h][i] = (unsigned)((row[h][i] * K + C) * 2); } }
    __device__ __forceinline__ void get(const Unit& u, int tid, int K, unsigned (&off)[2][2]) const { int row[2][2]; rows(u, tid, row); offs(row, tid, K, off); } };

__device__ __forceinline__ unsigned cvt_pk_bf16(float lo, float hi) { unsigned r; asm volatile("v_cvt_pk_bf16_f32 %0, %1, %2" : "=v"(r) : "v"(lo), "v"(hi)); return r; }

typedef f32x4 Acc[2][2][4][2];
typedef int v8i __attribute__((ext_vector_type(8)));
typedef int v4i __attribute__((ext_vector_type(4)));
__device__ __forceinline__ f32x4 acc_i2f(f32x4 v) { const v4i i = __builtin_bit_cast(v4i, v); return (f32x4){(float)i.x, (float)i.y, (float)i.z, (float)i.w}; }
typedef short bf16x16 __attribute__((ext_vector_type(16)));

constexpr int IMAGIC = 0x4B400000; constexpr float FMAGIC = 12582912.f;
template <bool AI = false> struct EpiBf16 {
    static constexpr bool PERM = true; static constexpr int MID_T = 0; static constexpr bool HAS_PRE = true; static constexpr bool MAGIC = AI;
    bf16* O; int ldc; float asc; const float* rs; int sig_from = 1 << 30;
    __device__ __forceinline__ void mid(Acc&, const Unit&, int, int, int, int) const {}
    __device__ __forceinline__ void prefetch(const Unit& u, int wr, int fr, float (&p)[8]) const {
        if (rs) {
#pragma unroll
            for (int i = 0; i < 8; ++i) p[i] = rs[u.pm * BM + wr * 64 + fr + (i >> 2) * HALF + (i & 3) * 16]; } }
    __device__ __forceinline__ void operator()(const Acc& acc, const Unit& u, int wr, int wc, int fr, int fq, const float* pre = nullptr) const {
        const int row0 = u.pm * BM + wr * 64 + fr, col0 = u.pn * BM + wc * 32 + 8 * fq;
#pragma unroll
        for (int ai = 0; ai < 2; ++ai)
#pragma unroll
            for (int m = 0; m < 4; ++m) { bf16* rowp = O + (size_t)(row0 + ai * HALF + m * 16) * ldc + col0; const float sc = rs ? asc * (pre ? pre[ai * 4 + m] : rs[row0 + ai * HALF + m * 16]) : asc; const float nb = AI ? -FMAGIC * sc : 0.f;
#pragma unroll
                for (int bj = 0; bj < 2; ++bj) { const f32x4 v0 = AI ? __builtin_elementwise_fma(acc[ai][bj][m][0], (f32x4){sc, sc, sc, sc}, (f32x4){nb, nb, nb, nb}) : acc[ai][bj][m][0] * sc, v1 = AI ? __builtin_elementwise_fma(acc[ai][bj][m][1], (f32x4){sc, sc, sc, sc}, (f32x4){nb, nb, nb, nb}) : acc[ai][bj][m][1] * sc;
                    f32x4 s0 = v0, s1 = v1;
                    if (u.pn >= sig_from) {
                        const float sc2 = -LOG2E * sc, nb2 = -LOG2E * nb;
                        const f32x4 t0 = AI ? __builtin_elementwise_fma(acc[ai][bj][m][0], (f32x4){sc2, sc2, sc2, sc2}, (f32x4){nb2, nb2, nb2, nb2}) : acc[ai][bj][m][0] * sc2, t1 = AI ? __builtin_elementwise_fma(acc[ai][bj][m][1], (f32x4){sc2, sc2, sc2, sc2}, (f32x4){nb2, nb2, nb2, nb2}) : acc[ai][bj][m][1] * sc2;
                        const f32x4 d0 = (f32x4){__builtin_amdgcn_exp2f(t0[0]), __builtin_amdgcn_exp2f(t0[1]), __builtin_amdgcn_exp2f(t0[2]), __builtin_amdgcn_exp2f(t0[3])} + 1.f, d1 = (f32x4){__builtin_amdgcn_exp2f(t1[0]), __builtin_amdgcn_exp2f(t1[1]), __builtin_amdgcn_exp2f(t1[2]), __builtin_amdgcn_exp2f(t1[3])} + 1.f;
                        s0 = (f32x4){__builtin_amdgcn_rcpf(d0[0]), __builtin_amdgcn_rcpf(d0[1]), __builtin_amdgcn_rcpf(d0[2]), __builtin_amdgcn_rcpf(d0[3])}; s1 = (f32x4){__builtin_amdgcn_rcpf(d1[0]), __builtin_amdgcn_rcpf(d1[1]), __builtin_amdgcn_rcpf(d1[2]), __builtin_amdgcn_rcpf(d1[3])}; }
                    u32x4 w; w.x = cvt_pk_bf16(s0[0], s0[1]); w.y = cvt_pk_bf16(s0[2], s0[3]); w.z = cvt_pk_bf16(s1[0], s1[1]); w.w = cvt_pk_bf16(s1[2], s1[3]);
                    __builtin_nontemporal_store(w, (u32x4*)(rowp + bj * HALF)); } }
    }
};
struct EpiMerge {
    static constexpr bool PERM = true; static constexpr int MID_T = 8; static constexpr bool HAS_PRE = false; static constexpr bool MAGIC = false;
    const bf16* proj; bf16* Y;
    __device__ __forceinline__ void mid(Acc& acc, const Unit& u, int wr, int wc, int fr, int fq) const {
        int row0 = u.pm * BM + wr * 64 + fr, col0 = u.pn * BM + wc * 32 + 8 * fq;
        asm volatile("" : "+v"(row0), "+v"(col0));
        u32x4 ga[2][2], gb[2][2];
#define MG_LOAD(g, buf) do { const bf16* rp_ = proj + (size_t)(row0 + ((g) >> 2) * HALF + ((g) & 3) * 16) * DIN + col0; \
            ga[buf][0] = *(const u32x4*)(rp_ + C_GA); ga[buf][1] = *(const u32x4*)(rp_ + C_GA + HALF); gb[buf][0] = *(const u32x4*)(rp_ + C_GB); gb[buf][1] = *(const u32x4*)(rp_ + C_GB + HALF); } while (0)
        MG_LOAD(0, 0);
#pragma unroll
        for (int g = 0; g < 8; ++g) { const int ai = g >> 2, m = g & 3, cur = g & 1;
            if (g < 7) MG_LOAD(g + 1, cur ^ 1);
            asm volatile("" ::: "memory");
#pragma unroll
            for (int bj = 0; bj < 2; ++bj) { const u32x4 a = ga[cur][bj], b = gb[cur][bj]; float r[8];
#pragma unroll
                for (int q = 0; q < 4; ++q) { r[2 * q] = bflo(a[q]) * __builtin_amdgcn_rcpf(bflo(b[q])); r[2 * q + 1] = bfhi(a[q]) * __builtin_amdgcn_rcpf(bfhi(b[q])); }
                acc[ai][bj][m][0] = acc[ai][bj][m][0] * (f32x4){r[0], r[1], r[2], r[3]}; acc[ai][bj][m][1] = acc[ai][bj][m][1] * (f32x4){r[4], r[5], r[6], r[7]}; }
            asm volatile("" : "+v"(acc[ai][0][m][0]), "+v"(acc[ai][0][m][1]), "+v"(acc[ai][1][m][0]), "+v"(acc[ai][1][m][1]) :: "memory"); }
#undef MG_LOAD
    }
    __device__ __forceinline__ void operator()(const Acc& acc, const Unit& u, int wr, int wc, int fr, int fq) const {
        const int row0 = u.pm * BM + wr * 64 + fr, col0 = u.pn * BM + wc * 32 + 8 * fq;
#pragma unroll
        for (int ai = 0; ai < 2; ++ai)
#pragma unroll
            for (int m = 0; m < 4; ++m) { const size_t row = (size_t)(row0 + ai * HALF + m * 16);
#pragma unroll
                for (int bj = 0; bj < 2; ++bj) { const u32x4 b = *(const u32x4*)(proj + row * DIN + C_GB + col0 + bj * HALF);
                    const f32x4 v0 = acc[ai][bj][m][0], v1 = acc[ai][bj][m][1];
                    u32x4 w; w.x = cvt_pk_bf16(v0[0] * bflo(b.x), v0[1] * bfhi(b.x)); w.y = cvt_pk_bf16(v0[2] * bflo(b.y), v0[3] * bfhi(b.y));
                    w.z = cvt_pk_bf16(v1[0] * bflo(b.z), v1[1] * bfhi(b.z)); w.w = cvt_pk_bf16(v1[2] * bflo(b.w), v1[3] * bfhi(b.w));
                    *(u32x4*)(Y + row * D + col0 + bj * HALF) = w; } }
    }
};
template <bool BF32> struct EpiRes {
    static constexpr bool PERM = false; static constexpr int MID_T = 0; static constexpr bool HAS_PRE = false; static constexpr bool MAGIC = false;
    const void* base; bf16* out; const float* gate; float asc;
    __device__ __forceinline__ void mid(Acc&, const Unit&, int, int, int, int) const {}
    __device__ __forceinline__ void operator()(const Acc& acc, const Unit& u, int wr, int wc, int fr, int fq) const {
        const int b = (u.pm * BM) / SEQ, col0 = u.pn * BM + wc * 32 + 4 * fq;
        f32x4 gv[2][2];
#pragma unroll
        for (int bj = 0; bj < 2; ++bj)
#pragma unroll
            for (int n = 0; n < 2; ++n) gv[bj][n] = *(const f32x4*)(gate + (size_t)b * ADA_N + col0 + bj * HALF + n * 16) * asc;
#pragma unroll
        for (int ai = 0; ai < 2; ++ai)
#pragma unroll
            for (int m = 0; m < 4; ++m) { const size_t off = (size_t)(u.pm * BM + ai * HALF + wr * 64 + m * 16 + fr) * D + col0;
#pragma unroll
                for (int bj = 0; bj < 2; ++bj)
#pragma unroll
                    for (int n = 0; n < 2; ++n) { f32x4 bs;
                        if constexpr (BF32) bs = *(const f32x4*)((const float*)base + off + bj * HALF + n * 16);
                        else { const u32x2 w = *(const u32x2*)((const bf16*)base + off + bj * HALF + n * 16); bs = (f32x4){bflo(w.x), bfhi(w.x), bflo(w.y), bfhi(w.y)}; }
                        const f32x4 o = bs + gv[bj][n] * acc[ai][bj][m][n];
                        u32x2 w; w.x = cvt_pk_bf16(o[0], o[1]); w.y = cvt_pk_bf16(o[2], o[3]); *(u32x2*)(out + off + bj * HALF + n * 16) = w; } }
    }
};
template <bool F8O, bool AI = false> struct EpiSwiglu {
    static constexpr bool PERM = true; static constexpr int MID_T = 0; static constexpr bool HAS_PRE = true; static constexpr bool MAGIC = AI;
    void* Hd; int ldh, nN; float asc; const float* rs; const int* rl;
    __device__ __forceinline__ void mid(Acc&, const Unit&, int, int, int, int) const {}
    __device__ __forceinline__ void prefetch(const Unit& u, int wr, int fr, float (&p)[8]) const {
        if (rs) {
#pragma unroll
            for (int i = 0; i < 8; ++i) { const int rr_ = u.pm * BM + wr * 64 + fr + (i >> 2) * HALF + (i & 3) * 16; p[i] = rs[rl ? rl[rr_] : rr_]; } } }
    __device__ __forceinline__ void operator()(const Acc& acc, const Unit& u, int wr, int wc, int fr, int fq, const float* pre = nullptr) const {
        const int row0 = u.pm * BM + wr * 64 + fr, col0 = (u.pn - u.e * nN) * HALF + wc * 32 + 8 * fq;
#pragma unroll
        for (int ai = 0; ai < 2; ++ai)
#pragma unroll
            for (int m = 0; m < 4; ++m) { float h[8]; const int rr_ = row0 + ai * HALF + m * 16; const float sc = rs ? asc * (pre ? pre[ai * 4 + m] : rs[rl ? rl[rr_] : rr_]) : asc; const float nb = AI ? -FMAGIC * sc : 0.f, sc2 = -LOG2E * sc, nb2 = -LOG2E * nb;
#pragma unroll
                for (int n = 0; n < 2; ++n) { const f32x4 av = AI ? __builtin_elementwise_fma(acc[ai][0][m][n], (f32x4){sc, sc, sc, sc}, (f32x4){nb, nb, nb, nb}) : acc[ai][0][m][n] * sc, gv = AI ? __builtin_elementwise_fma(acc[ai][1][m][n], (f32x4){sc, sc, sc, sc}, (f32x4){nb, nb, nb, nb}) : acc[ai][1][m][n] * sc;
                    const f32x4 tv = AI ? __builtin_elementwise_fma(acc[ai][0][m][n], (f32x4){sc2, sc2, sc2, sc2}, (f32x4){nb2, nb2, nb2, nb2}) : acc[ai][0][m][n] * sc2;
                    const f32x4 dv = (f32x4){__builtin_amdgcn_exp2f(tv[0]), __builtin_amdgcn_exp2f(tv[1]), __builtin_amdgcn_exp2f(tv[2]), __builtin_amdgcn_exp2f(tv[3])} + 1.f;
                    const f32x4 hv = (av * gv) * (f32x4){__builtin_amdgcn_rcpf(dv[0]), __builtin_amdgcn_rcpf(dv[1]), __builtin_amdgcn_rcpf(dv[2]), __builtin_amdgcn_rcpf(dv[3])};
#pragma unroll
                    for (int q = 0; q < 4; ++q) h[4 * n + q] = hv[q]; }
                if constexpr (F8O) { u32x2 w; w.x = pk4_fp8(h[0], h[1], h[2], h[3]); w.y = pk4_fp8(h[4], h[5], h[6], h[7]);
                    __builtin_nontemporal_store(w, (u32x2*)((unsigned char*)Hd + (size_t)(row0 + ai * HALF + m * 16) * ldh + col0)); }
                else { u32x4 w; w.x = cvt_pk_bf16(h[0], h[1]); w.y = cvt_pk_bf16(h[2], h[3]); w.z = cvt_pk_bf16(h[4], h[5]); w.w = cvt_pk_bf16(h[6], h[7]);
                    __builtin_nontemporal_store(w, (u32x4*)((bf16*)Hd + (size_t)(row0 + ai * HALF + m * 16) * ldh + col0)); } }
    }
};
template <bool LAST> struct EpiMoeDown {
    static constexpr bool PERM = false; static constexpr int MID_T = 0; static constexpr bool HAS_PRE = false; static constexpr bool MAGIC = false;
    bf16* x; float* out; const float* gate; const int* list; const float* wl; float asc;
    __device__ __forceinline__ void mid(Acc&, const Unit&, int, int, int, int) const {}
    __device__ __forceinline__ void operator()(const Acc& acc, const Unit& u, int wr, int wc, int fr, int fq) const {
        const int col0 = (u.pn - u.e * 4) * BM + wc * 32 + 4 * fq;
#pragma unroll
        for (int ai = 0; ai < 2; ++ai)
#pragma unroll
            for (int m = 0; m < 4; ++m) { const int lr = ai * HALF + wr * 64 + m * 16 + fr;
                if (lr < u.nvalid) { const int sr = u.pm * BM + lr; const int tok = list[sr]; const float w = wl[sr] * asc; const int b = tok / SEQ;
                    bf16* xr = x + (size_t)tok * D + col0; float* orow = out + (size_t)tok * D + col0; const float* gr = gate + (size_t)b * ADA_N + col0;
#pragma unroll
                    for (int bj = 0; bj < 2; ++bj)
#pragma unroll
                        for (int n = 0; n < 2; ++n) { const f32x4 gv = *(const f32x4*)(gr + bj * HALF + n * 16); const u32x2 xw = *(const u32x2*)(xr + bj * HALF + n * 16);
                            const f32x4 o = (f32x4){bflo(xw.x), bfhi(xw.x), bflo(xw.y), bfhi(xw.y)} + gv * w * acc[ai][bj][m][n];
                            if constexpr (LAST) *(f32x4*)(orow + bj * HALF + n * 16) = o;
                            else { u32x2 ow; ow.x = cvt_pk_bf16(o[0], o[1]); ow.y = cvt_pk_bf16(o[2], o[3]); *(u32x2*)(xr + bj * HALF + n * 16) = ow; } } } }
    }
};

template <class Epi, class Sched, class AOff, bool ALIGN_EPI, int QM = 0>
__device__ __forceinline__ void gemm_phase(LAS unsigned char* lds, const Gemm g, const Sched& S, const AOff& AO, const Epi& E) {
    constexpr bool GA = AOff::GATHER; constexpr bool F8 = QM == 1; constexpr bool MB = (QM == 2) && Epi::MAGIC;
    int tid_ = threadIdx.x; asm volatile("" : "+v"(tid_));
    const int tid = tid_, wid = __builtin_amdgcn_readfirstlane(tid >> 6), lane = tid & 63, wr = wid >> 2, wc = wid & 3, fr = lane & 15, fq = lane >> 4;
    const int K = g.K, nt = K / BK;
    unsigned voffA[2], voffB[2];
#pragma unroll
    for (int i = 0; i < 2; ++i) { int R, C; stage_rc(tid * 16 + i * 8192, R, C); const int Rb = Epi::PERM ? ((R & ~31) + perm32(R & 31)) : R; voffA[i] = (unsigned)(R * K + C) * 2u; voffB[i] = (unsigned)(Rb * K + C) * 2u; }
    const size_t kstep = (size_t)(BK * 2);
    const size_t hstep = (size_t)HALF * K * 2;
    const size_t tstep = 2 * hstep;
    const unsigned ldsw = (unsigned)wid * 1024u;
    const int aoff = lds_byte(wr * 64 + fr, fq * 8), boff = lds_byte(wc * 32 + fr, fq * 8);
#define PG8_SA(b, h) (((b) * 2 + (h)) * HTB)
#define PG8_SB(b, h) ((4 + (b) * 2 + (h)) * HTB)
#define PG8_STAGE(bufoff, gbase, voff) do { _Pragma("unroll") for (int _i = 0; _i < 2; ++_i) \
        __builtin_amdgcn_global_load_lds((const unsigned*)((const char*)(gbase) + (voff)[_i]), (LAS unsigned*)(lds + (bufoff) + ldsw + _i * 8192), 16, 0, 0); } while (0)
#define PG8_STAGE_A(bufoff, ub, h) do { if constexpr (GA) { PG8_STAGE(bufoff, ub, gOff[h]); } else { PG8_STAGE(bufoff, (ub) + (h) * hstep, voffA); } } while (0)
#define PG8_LD2(dst, addr) do { const u32x4 lo_ = *(const LAS u32x4*)(addr), hi_ = *(const LAS u32x4*)((addr) + 1024); dst = (Frag){lo_.x, lo_.y, lo_.z, lo_.w, hi_.x, hi_.y, hi_.z, hi_.w}; } while (0)
#define PG8_LDA(dst, b, h) do { _Pragma("unroll") for (int m = 0; m < 4; ++m) PG8_LD2(dst[m], lds + PG8_SA(b, h) + aoff + m * 2048); } while (0)
#define PG8_LDB(dst, b, h) do { _Pragma("unroll") for (int n = 0; n < 2; ++n) PG8_LD2(dst[n], lds + PG8_SB(b, h) + boff + n * 2048); } while (0)
#define PG8_HALF(x, k) __builtin_bit_cast(bf16x8, (u32x4){x[4 * (k)], x[4 * (k) + 1], x[4 * (k) + 2], x[4 * (k) + 3]})
#define PG8_MMA(ai, bj, At, Bt) do { __builtin_amdgcn_s_setprio(1); if constexpr (F8) { _Pragma("unroll") for (int m = 0; m < 4; ++m) _Pragma("unroll") for (int n = 0; n < 2; ++n) \
        asm volatile("v_mfma_scale_f32_16x16x128_f8f6f4 %0, %1, %2, %0, %3, %3 op_sel_hi:[0,0,0]" : "+v"(acc[ai][bj][m][n]) : "v"(Bt[n]), "v"(At[m]), "v"(sc1)); } else { \
        _Pragma("unroll") for (int m = 0; m < 4; ++m) _Pragma("unroll") for (int n = 0; n < 2; ++n) _Pragma("unroll") for (int k = 0; k < 2; ++k) \
        { if constexpr (QM == 2) acc[ai][bj][m][n] = __builtin_bit_cast(f32x4, __builtin_amdgcn_mfma_i32_16x16x64_i8(__builtin_bit_cast(v4i, PG8_HALF(Bt[n], k)), __builtin_bit_cast(v4i, PG8_HALF(At[m], k)), __builtin_bit_cast(v4i, acc[ai][bj][m][n]), 0, 0, 0)); \
          else acc[ai][bj][m][n] = __builtin_amdgcn_mfma_f32_16x16x32_bf16(PG8_HALF(Bt[n], k), PG8_HALF(At[m], k), acc[ai][bj][m][n], 0, 0, 0); } } __builtin_amdgcn_s_setprio(0); } while (0)
#define PG8_WAIT_V(n) asm volatile("s_waitcnt vmcnt(" #n ")" ::: "memory")
#define PG8_WAIT_L(n) asm volatile("s_waitcnt lgkmcnt(" #n ")" ::: "memory")
#define PG8_BAR __builtin_amdgcn_s_barrier()
#define PG8_SCHED __builtin_amdgcn_sched_barrier(0)
    Unit cur, nxt; int ui = 0;
    if (!S.next(0, cur)) return;
    unsigned gOff[2][2];
    if constexpr (GA) AO.get(cur, tid, K, gOff);
    Acc acc;
#pragma unroll
    for (int a = 0; a < 2; ++a)
#pragma unroll
        for (int b = 0; b < 2; ++b)
#pragma unroll
            for (int m = 0; m < 4; ++m)
#pragma unroll
                for (int n = 0; n < 2; ++n) { if constexpr (MB) acc[a][b][m][n] = __builtin_bit_cast(f32x4, (v4i){IMAGIC, IMAGIC, IMAGIC, IMAGIC}); else acc[a][b][m][n] = (f32x4){0.f, 0.f, 0.f, 0.f}; if constexpr (QM == 2) asm volatile("" : "+v"(acc[a][b][m][n])); }
    typedef unsigned Frag __attribute__((ext_vector_type(8)));
    Frag At[4], B0[2], B1[2];
    unsigned sc1 = 0x7F7F7F7Fu; asm volatile("" : "+v"(sc1));
    const char* cA = (const char*)g.A + (GA ? (size_t)0 : (size_t)cur.pm * tstep); const char* cB = (const char*)g.Bt + (size_t)cur.pn * tstep;
    PG8_STAGE(PG8_SB(0, 0), cB, voffB); PG8_STAGE(PG8_SB(0, 1), cB + hstep, voffB); PG8_STAGE_A(PG8_SA(0, 0), cA, 0); PG8_STAGE_A(PG8_SA(0, 1), cA, 1);
    if (wr == 1) PG8_BAR;
    PG8_WAIT_V(2); PG8_BAR;
    PG8_STAGE(PG8_SB(1, 0), cB + kstep, voffB); PG8_STAGE_A(PG8_SA(1, 0), cA + kstep, 0); PG8_STAGE(PG8_SB(1, 1), cB + hstep + kstep, voffB);
    PG8_WAIT_V(6); PG8_BAR;
    for (;;) {
        const bool has_next = S.next(ui + 1, nxt);
        float pre[8];
        int nrow[2][2]; if constexpr (GA) { if (has_next) AO.rows(nxt, tid, nrow); }
        const char* nA = (GA || !has_next) ? cA : (const char*)g.A + (size_t)nxt.pm * tstep; const char* nB = has_next ? (const char*)g.Bt + (size_t)nxt.pn * tstep : cB;
#pragma nounroll
        for (int t = 0; t < nt; t += 2) {
            if (Epi::MID_T != 0 && t == Epi::MID_T) E.mid(acc, cur, wr, wc, fr, fq);
            const bool last = (t == nt - 2);
            const char* a1 = cA + (size_t)(t + 1) * kstep;
            PG8_LDB(B0, 0, 0); PG8_LDB(B1, 0, 1); PG8_SCHED; PG8_LDA(At, 0, 0); PG8_STAGE_A(PG8_SA(1, 1), a1, 1);
            if (last) { cA = nA; if constexpr (GA) { if (has_next) AO.offs(nrow, tid, K, gOff); } }
            if constexpr (Epi::HAS_PRE) { if (last) E.prefetch(cur, wr, fr, pre); }
            const char* a2 = last ? cA : cA + (size_t)(t + 2) * kstep; const char* b2 = last ? nB : cB + (size_t)(t + 2) * kstep;
            const char* a3 = a2 + kstep; const char* b3 = b2 + kstep;
            PG8_WAIT_V(8); PG8_WAIT_L(0); PG8_BAR; PG8_MMA(0, 0, At, B0); PG8_MMA(0, 1, At, B1); PG8_BAR; PG8_SCHED;
            PG8_LDA(At, 0, 1); PG8_STAGE(PG8_SB(0, 0), b2, voffB); PG8_STAGE(PG8_SB(0, 1), b2 + hstep, voffB); PG8_STAGE_A(PG8_SA(0, 0), a2, 0);
            PG8_WAIT_V(8); PG8_WAIT_L(0); PG8_BAR; PG8_MMA(1, 0, At, B0); PG8_MMA(1, 1, At, B1); PG8_BAR; PG8_SCHED;
            PG8_LDB(B0, 1, 0); PG8_LDB(B1, 1, 1); PG8_SCHED; PG8_LDA(At, 1, 0); PG8_STAGE_A(PG8_SA(0, 1), a2, 1);
            PG8_WAIT_V(8); PG8_WAIT_L(0); PG8_BAR; PG8_MMA(0, 0, At, B0); PG8_MMA(0, 1, At, B1); PG8_BAR; PG8_SCHED;
            PG8_LDA(At, 1, 1); PG8_STAGE(PG8_SB(1, 0), b3, voffB); PG8_STAGE(PG8_SB(1, 1), b3 + hstep, voffB); PG8_STAGE_A(PG8_SA(1, 0), a3, 0);
            PG8_WAIT_V(8); PG8_WAIT_L(0); PG8_BAR; PG8_MMA(1, 0, At, B0); PG8_MMA(1, 1, At, B1); PG8_BAR; PG8_SCHED;
        }
        if constexpr (F8) asm volatile("s_nop 15\n\ts_nop 15" ::: "memory");
        if constexpr (ALIGN_EPI) { if (wr == 0) PG8_BAR; }
        if constexpr (QM == 2 && !MB) {
#pragma unroll
            for (int a = 0; a < 2; ++a)
#pragma unroll
                for (int b = 0; b < 2; ++b)
#pragma unroll
                    for (int m = 0; m < 4; ++m)
#pragma unroll
                        for (int n = 0; n < 2; ++n) acc[a][b][m][n] = acc_i2f(acc[a][b][m][n]); }
        { int te_ = threadIdx.x; asm volatile("" : "+v"(te_));
          const int le_ = te_ & 63; if constexpr (Epi::HAS_PRE) E(acc, cur, wr, wc, le_ & 15, le_ >> 4, pre); else E(acc, cur, wr, wc, le_ & 15, le_ >> 4); }
        if (!has_next) break;
#pragma unroll
        for (int a = 0; a < 2; ++a)
#pragma unroll
            for (int b = 0; b < 2; ++b)
#pragma unroll
                for (int m = 0; m < 4; ++m)
#pragma unroll
                    for (int n = 0; n < 2; ++n) { if constexpr (MB) acc[a][b][m][n] = __builtin_bit_cast(f32x4, (v4i){IMAGIC, IMAGIC, IMAGIC, IMAGIC}); else acc[a][b][m][n] = (f32x4){0.f, 0.f, 0.f, 0.f}; if constexpr (QM == 2) asm volatile("" : "+v"(acc[a][b][m][n])); }
        cur = nxt; cB = nB; ++ui;
        if constexpr (ALIGN_EPI) { if (wr == 1) PG8_BAR; }
    }
    PG8_WAIT_V(0);
    if constexpr (!ALIGN_EPI) { if (wr == 0) PG8_BAR; }
    PG8_BAR;
#undef PG8_SA
#undef PG8_SB
#undef PG8_STAGE
#undef PG8_STAGE_A
#undef PG8_LDA
#undef PG8_LDB
#undef PG8_MMA
#undef PG8_HALF
#undef PG8_LD2
#undef PG8_WAIT_V
#undef PG8_WAIT_L
#undef PG8_BAR
#undef PG8_SCHED
}
}

#define XB_TMO      128
#define XB_XCNT(j)  (256  + 64 * (j))
#define XB_XSUB(j)  (1280 + 64 * (j))
#define XB_XGEN(j)  (2304 + 64 * (j))
#define XB_TOP      3328
#define XB_TOPGEN   3392
#define XCD_BAR_WORDS 3456
#define XB_SPIN_CAP (1u << 23)
__device__ __forceinline__ unsigned xb_ld(unsigned* p)              { return __hip_atomic_load(p, __ATOMIC_RELAXED, __HIP_MEMORY_SCOPE_AGENT); }
__device__ __forceinline__ unsigned xb_add(unsigned* p, unsigned v) { return __hip_atomic_fetch_add(p, v, __ATOMIC_RELAXED, __HIP_MEMORY_SCOPE_AGENT); }
__device__ __forceinline__ unsigned xb_xcc_id() { return (unsigned)__builtin_amdgcn_s_getreg((3 << 11) | 20) & 0xFu; }
#define XB_SPIN(cond, bar) do { unsigned _sp = 0; while (cond) { __builtin_amdgcn_s_sleep(1); \
    if ((++_sp & 255u) == 0u) { if (xb_ld(&(bar)[XB_TMO])) break; if (_sp > XB_SPIN_CAP) { atomicAdd(&(bar)[XB_TMO], 1u); break; } } } } while (0)
struct XcdBarrier { unsigned* bar; unsigned x; volatile LAS unsigned* st; };
__device__ __forceinline__ XcdBarrier xcd_barrier_post(unsigned* bar, volatile LAS unsigned* st) {
    XcdBarrier b; b.bar = bar; b.x = xb_xcc_id(); b.st = st;
    if (threadIdx.x == 0) (void)xb_add(&bar[XB_XCNT(b.x)], 1u);
    return b;
}
__device__ __forceinline__ void xcd_barrier_complete(unsigned* bar, unsigned x, unsigned& nloc, unsigned& nx) {
    const unsigned G = gridDim.x * gridDim.y * gridDim.z;
    unsigned sum, cnt, mine, sp = 0u;
    for (;;) {
        sum = 0u; cnt = 0u; mine = 0u;
#pragma unroll
        for (unsigned j = 0; j < 16; ++j) { const unsigned c = xb_ld(&bar[XB_XCNT(j)]); sum += c; cnt += (c > 0u) ? 1u : 0u; mine = (j == x) ? c : mine; }
        if (sum == G) break;
        __builtin_amdgcn_s_sleep(1);
        if ((++sp & 255u) == 0u) { if (xb_ld(&bar[XB_TMO])) break; if (sp > XB_SPIN_CAP) { atomicAdd(&bar[XB_TMO], 1u); break; } }
    }
    nloc = mine > 0u ? mine : 1u; nx = cnt > 0u ? cnt : 1u;
}
__device__ __forceinline__ void xcd_barrier(const XcdBarrier& b) {
    asm volatile("s_waitcnt vmcnt(0)" ::: "memory");
    __syncthreads();
    if (threadIdx.x == 0) {
        unsigned* bar = b.bar; unsigned bx_ = __builtin_amdgcn_readfirstlane(b.x);
        asm volatile("" : "+s"(bar), "+s"(bx_));
        __builtin_amdgcn_s_waitcnt(0);
        unsigned nloc = b.st[0], nx = b.st[1];
        if (nloc == 0u) { xcd_barrier_complete(bar, bx_, nloc, nx); b.st[0] = nloc; b.st[1] = nx; }
        const unsigned old = xb_add(&bar[XB_XSUB(bx_)], 1u);
        const unsigned gen = old / nloc;
        if (old + 1u == (gen + 1u) * nloc) {
            __builtin_amdgcn_fence(__ATOMIC_RELEASE, "agent");
            asm volatile("s_waitcnt vmcnt(0)" ::: "memory");
            const unsigned og = xb_add(&bar[XB_TOP], 1u);
            const unsigned tg = og / nx;
            if (og + 1u == (tg + 1u) * nx) xb_add(&bar[XB_TOPGEN], 1u);
            else XB_SPIN(xb_ld(&bar[XB_TOPGEN]) == tg, bar);
            __builtin_amdgcn_fence(__ATOMIC_ACQUIRE, "agent");
            xb_add(&bar[XB_XGEN(bx_)], 1u);
            asm volatile("s_waitcnt vmcnt(0)" ::: "memory");
        } else {
            XB_SPIN(xb_ld(&bar[XB_XGEN(bx_)]) == gen, bar);
            __builtin_amdgcn_fence(__ATOMIC_ACQUIRE, "agent");
            asm volatile("s_waitcnt vmcnt(0)" ::: "memory");
        }
    }
    __syncthreads();
}

struct Frame {
    LAS unsigned char* lds;
    volatile LAS unsigned* LC;
    gu32* ctl;
    int tid, lane, wave, vcu, G, bx;
    unsigned char* ws;
    float* adaf;
};

__device__ __forceinline__ void transpose_item(const float* W, int N, bf16* WT, int ldk, int koff, int mode, LAS float* scr, int item, int lane) {
    const int nblk = N / 32, kb = item / nblk, nb = item % nblk, k0 = 64 * kb, n0 = 32 * nb;
#pragma unroll 8
    for (int i = 0; i < 32; ++i) { const int kk = 2 * i + (lane >> 5); scr[kk * 33 + (lane & 31)] = W[(size_t)(k0 + kk) * N + n0 + (lane & 31)]; }
    LDS_WAIT(); asm volatile("" ::: "memory");
    const int c = lane & 7;
    const int d0 = mode == 0 ? n0 : ((n0 >> 7) * 256 + (mode == 2 ? 128 : 0) + (n0 & 127));
#pragma unroll
    for (int j = 0; j < 4; ++j) { const int n = (lane >> 3) + 8 * j; const LAS float* s = scr + (8 * c) * 33 + n;
        u32x4 o; o.x = pk2(s[0 * 33], s[1 * 33]); o.y = pk2(s[2 * 33], s[3 * 33]); o.z = pk2(s[4 * 33], s[5 * 33]); o.w = pk2(s[6 * 33], s[7 * 33]);
        *(u32x4*)(WT + (size_t)(d0 + n) * ldk + koff + k0 + 8 * c) = o; }
    LDS_WAIT(); asm volatile("" ::: "memory");
}

#define PHASE_ENTER(F) do { int t_ = threadIdx.x; asm volatile("" : "+v"(t_)); (F).tid = t_; (F).lane = t_ & 63; (F).wave = __builtin_amdgcn_readfirstlane(t_ >> 6); \
    int b_ = blockIdx.x; asm volatile("" : "+s"(b_)); (F).bx = b_; (F).vcu = ((F).G % 8 == 0) ? (b_ % 8) * ((F).G / 8) + b_ / 8 : b_; } while (0)
__device__ __forceinline__ void transpose_item_f8(const float* W, int N, unsigned char* WT, int ldk, int koff, int mode, LAS float* scr, int item, int lane, int nblk_ = 0) {
    const int nblk = nblk_ ? nblk_ : N / 32, kb = item / nblk, nb = item % nblk, k0 = 64 * kb, n0 = 32 * nb;
#pragma unroll 8
    for (int i = 0; i < 32; ++i) { const int kk = 2 * i + (lane >> 5); scr[kk * 33 + (lane & 31)] = W[(size_t)(k0 + kk) * N + n0 + (lane & 31)] * W8_SCALE; }
    LDS_WAIT(); asm volatile("" ::: "memory");
    const int c = lane & 7;
    const int d0 = mode == 0 ? n0 : ((n0 >> 7) * 256 + (mode == 2 ? 128 : 0) + (n0 & 127));
#pragma unroll
    for (int j = 0; j < 4; ++j) { const int n = (lane >> 3) + 8 * j; const LAS float* sp = scr + (8 * c) * 33 + n;
        u32x2 o; o.x = pk4_fp8(sp[0 * 33], sp[1 * 33], sp[2 * 33], sp[3 * 33]); o.y = pk4_fp8(sp[4 * 33], sp[5 * 33], sp[6 * 33], sp[7 * 33]);
        *(u32x2*)(WT + (size_t)(d0 + n) * ldk + koff + k0 + 8 * c) = o; }
    LDS_WAIT(); asm volatile("" ::: "memory");
}
__device__ __forceinline__ void transpose_item_i8(const float* W, int N, unsigned char* WT, int ldk, int koff, int mode, LAS float* scr, int item, int lane, int nblk_ = 0) {
    const int nblk = nblk_ ? nblk_ : N / 32, kb = item / nblk, nb = item % nblk, k0 = 64 * kb, n0 = 32 * nb;
#pragma unroll 8
    for (int i = 0; i < 32; ++i) { const int kk = 2 * i + (lane >> 5); scr[kk * 33 + (lane & 31)] = W[(size_t)(k0 + kk) * N + n0 + (lane & 31)] * QW_SCALE; }
    LDS_WAIT(); asm volatile("" ::: "memory");
    const int c = lane & 7;
    const int d0 = mode == 0 ? n0 : ((n0 >> 7) * 256 + (mode == 2 ? 128 : 0) + (n0 & 127));
#pragma unroll
    for (int j = 0; j < 4; ++j) { const int n = (lane >> 3) + 8 * j; const LAS float* sp = scr + (8 * c) * 33 + n;
        u32x2 o; o.x = pk4_i8(sp[0 * 33], sp[1 * 33], sp[2 * 33], sp[3 * 33]); o.y = pk4_i8(sp[4 * 33], sp[5 * 33], sp[6 * 33], sp[7 * 33]);
        *(u32x2*)(WT + (size_t)(d0 + n) * ldk + koff + k0 + 8 * c) = o; }
    LDS_WAIT(); asm volatile("" ::: "memory");
}
struct Args { const float* in[23]; float* out; unsigned char* ws; int pad0, pad1; };

__device__ __forceinline__ void phase_prologue(Frame& F, const Args& a, int part) {
    PHASE_ENTER(F);
    if (part == 0) {
    {
        LAS float* cs = (LAS float*)F.lds;
        LAS float* red = (LAS float*)(F.lds + 32768);
        if (F.bx < 2 * (ADA_N / 64)) {
            for (int i = F.tid; i < NB * D; i += NTHR) { const float c = a.in[1][i]; cs[i] = c * sigm(c); }
            __syncthreads();
            for (int it = F.bx; it < 2 * (ADA_N / 64); it += F.G) {
                const int l = it / (ADA_N / 64), j = (it % (ADA_N / 64)) * 64 + F.lane;
                const float* w = a.in[2] + (size_t)l * D * ADA_N + j;
                float acc[NB];
#pragma unroll
                for (int b = 0; b < NB; ++b) acc[b] = 0.f;
                for (int i = F.wave * 128; i < F.wave * 128 + 128; ++i) { const float wv = w[(size_t)i * ADA_N];
#pragma unroll
                    for (int b = 0; b < NB; ++b) acc[b] += cs[b * D + i] * wv; }
#pragma unroll
                for (int b = 0; b < NB; ++b) red[(F.wave * NB + b) * 64 + F.lane] = acc[b];
                __syncthreads();
                { const int b = F.tid >> 6, jj = F.tid & 63; float s = 0.f;
#pragma unroll
                  for (int w8 = 0; w8 < 8; ++w8) s += red[(w8 * NB + b) * 64 + jj];
                  const int col = (it % (ADA_N / 64)) * 64 + jj;
                  F.adaf[AO_ADA + ((size_t)l * NB + b) * ADA_N + col] = s + a.in[3][(size_t)l * ADA_N + col]; }
                __syncthreads();
            }
        }
        __syncthreads();
    }
    if (F.bx == F.G - 1) {
        { const int i = F.tid;
          const float l0 = a.in[7][i], l1 = a.in[7][512 + i];
          F.adaf[AO_LB + i] = 0.f; F.adaf[AO_LB + 512 + i] = 1.f / (1.f + __expf(l0 - l1)); }
        if (F.wave < 2) { const int l = F.wave; const float* lv = a.in[11] + l * 256;
            const float s1 = wave_sum(lv[F.lane] * lv[64 + F.lane]), s2 = wave_sum(lv[128 + F.lane] * lv[192 + F.lane]);
            const float li = 0.8f - 0.6f * __expf(-0.3f * (float)l);
            float mq = fabsf(a.in[9][l * 64 + F.lane]), mk = fabsf(a.in[10][l * 64 + F.lane]);
#pragma unroll
            for (int o = 1; o < 64; o <<= 1) { mq = fmaxf(mq, __shfl_xor(mq, o)); mk = fmaxf(mk, __shfl_xor(mk, o)); }
            const float B2 = 8.f * LOG2E * mq * mk * 1.05f;
            if (F.lane == 0) { F.adaf[AO_MISC + l * 8 + 0] = __expf(s1) - __expf(s2) + li; F.adaf[AO_MISC + l * 8 + 1] = li; F.adaf[AO_MISC + l * 8 + 2] = B2; }
            int cst[2], key[2];
#pragma unroll
            for (int e = 0; e < 2; ++e) { const int j = F.lane + 64 * e, h = j >> 5, qb = j & 31;
                const float win = (150.f + 2.f * B2) / (exp2f(-2.f * (float)(h + 1)) * LOG2E); const int wi = win < 8192.f ? (int)win + 1 : 8192;
                int ts = (128 * qb - wi) >> 6; if (ts < 0) ts = 0;
                cst[e] = 2 * qb + 2 - ts; key[e] = j; if (qb == 0 && F.lane < 64) F.adaf[AO_MISC + l * 8 + 3 + h] = (float)wi; }
            int rk[2] = {0, 0};
            for (int j2 = 0; j2 < 128; ++j2) { const int c2 = __shfl(cst[j2 >> 6], j2 & 63);
#pragma unroll
                for (int e = 0; e < 2; ++e) rk[e] += (c2 > cst[e] || (c2 == cst[e] && j2 < key[e])) ? 1 : 0; }
            int* ord = (int*)(F.adaf + AO_ORD) + l * 1024;
#pragma unroll
            for (int e = 0; e < 2; ++e) { const int h = key[e] >> 5, qb = key[e] & 31;
#pragma unroll
                for (int b = 0; b < NB; ++b) ord[rk[e] * 8 + b] = ((b * 4 + h) << 5) | qb; } }
    }
    }
    LAS float* scr = (LAS float*)(F.lds + F.wave * 16384);
    const int gw = F.vcu * NWAVES + F.wave, NGW = F.G * NWAVES;
    constexpr int I_IN = 16 * (DIN / 32), I_P = 8 * 32, I_O = 16 * 32, I_13 = 16 * (DFF / 32), I_2 = (DFF / 64) * 32;
    constexpr int I_G8a = 16 * (1024 / 32), I_G8 = 16 * (2560 / 32);
    constexpr int NIT = 2 * (I_IN + 2 * I_P + I_O) + 2 * I_13 + I_2;
    constexpr int NIT0 = I_IN + 2 * I_P + I_O;
    for (int it = (part == 0 ? 0 : NIT0) + gw; it < (part == 0 ? NIT0 : NIT); it += NGW) {
        int r = it; bool done = false;
#pragma unroll
        for (int l = 0; l < 2; ++l) {
            if (done) break;
            if (r < I_IN) { transpose_item_i8(a.in[6] + (size_t)l * D * DIN, DIN, a.ws + WS_WIN8 + (size_t)l * DIN * D, D, 0, 0, scr, r, F.lane); done = true; break; } r -= I_IN;
            if (r < I_P) { transpose_item(a.in[13] + (size_t)l * 512 * D, D, (bf16*)(a.ws + WS_WPAB) + (size_t)l * D * D, D, 0, 0, scr, r, F.lane); done = true; break; } r -= I_P;
            if (r < I_P) { transpose_item(a.in[14] + (size_t)l * 512 * D, D, (bf16*)(a.ws + WS_WPAB) + (size_t)l * D * D, D, 512, 0, scr, r, F.lane); done = true; break; } r -= I_P;
            if (r < I_O) { transpose_item(a.in[15] + (size_t)l * D * D, D, (bf16*)(a.ws + WS_WO) + (size_t)l * D * D, D, 0, 0, scr, r, F.lane); done = true; break; } r -= I_O;
        }
        if (done) continue;
        if (r < I_13) { transpose_item_i8(a.in[16], DFF, a.ws + WS_W13, D, 0, 1, scr, r, F.lane); continue; } r -= I_13;
        if (r < I_13) { transpose_item_i8(a.in[17], DFF, a.ws + WS_W13, D, 0, 2, scr, r, F.lane); continue; } r -= I_13;
        transpose_item(a.in[18], D, (bf16*)(a.ws + WS_W2), DFF, 0, 0, scr, r, F.lane);
    }
}
__device__ __forceinline__ void phase_moe_weights(Frame& F, const Args& a) {
    PHASE_ENTER(F);
    LAS float* scr = (LAS float*)(F.lds + F.wave * 16384);
    const int gw = F.vcu * NWAVES + F.wave, NGW = F.G * NWAVES;
    constexpr int I_1 = 16 * (DFFE / 32), I_2 = (DFFE / 64) * 32, PER_E = 2 * I_1 + I_2;
    for (int it = gw; it < NEXP * PER_E; it += NGW) {
        const int e = it / PER_E; int r = it % PER_E;
        if (r < I_1) { transpose_item_i8(a.in[20] + (size_t)e * D * DFFE, DFFE, a.ws + WS_MW13 + (size_t)e * 2 * DFFE * D, D, 0, 1, scr, r, F.lane); continue; } r -= I_1;
        if (r < I_1) { transpose_item_i8(a.in[21] + (size_t)e * D * DFFE, DFFE, a.ws + WS_MW13 + (size_t)e * 2 * DFFE * D, D, 0, 2, scr, r, F.lane); continue; } r -= I_1;
        transpose_item_f8(a.in[22] + (size_t)e * DFFE * D, D, a.ws + WS_MW2 + (size_t)e * D * DFFE, DFFE, 0, 0, scr, r, F.lane);
    }
}

template <bool MOE, int F8O, bool XB16>
__device__ __forceinline__ void phase_norm(Frame& F, const void* x, const float* gain, const float* ada_l, int sh_chunk, int sc_chunk, void* H, void* H2, float* rsv, const float* router, int* toke, float* tokw) {
    PHASE_ENTER(F);
    float rw[MOE ? 16 : 1][MOE ? 8 : 1];
    if constexpr (MOE) {
        for (int i = F.tid; i < 16; i += NTHR) F.LC[LC_LH + i] = 0u;
        __syncthreads();
#pragma unroll
        for (int j = 0; j < 4; ++j)
#pragma unroll
            for (int c = 0; c < 4; ++c) { const float* rp = router + (size_t)(256 * j + 4 * F.lane + c) * NEXP; const f32x4 r0 = *(const f32x4*)rp, r1 = *(const f32x4*)(rp + 4);
                rw[4 * j + c][0] = r0[0]; rw[4 * j + c][1] = r0[1]; rw[4 * j + c][2] = r0[2]; rw[4 * j + c][3] = r0[3]; rw[4 * j + c][4] = r1[0]; rw[4 * j + c][5] = r1[1]; rw[4 * j + c][6] = r1[2]; rw[4 * j + c][7] = r1[3]; }
    }
    const int rows_per = (M + F.G - 1) / F.G, r0 = F.bx * rows_per, r1 = (r0 + rows_per < M) ? r0 + rows_per : M;
    f32x4 nf[4]; u32x2 nh[4];
#define NORM_LOAD(mm) do { if ((mm) < r1) { _Pragma("unroll") for (int j = 0; j < 4; ++j) { if constexpr (XB16) nh[j] = ((const u32x2*)((const bf16*)x + (size_t)(mm) * D) + F.lane)[64 * j]; else nf[j] = ((const f32x4*)((const float*)x + (size_t)(mm) * D) + F.lane)[64 * j]; } } } while (0)
    NORM_LOAD(r0 + F.wave);
    for (int m = r0 + F.wave; m < r1; m += NWAVES) {
        const int b = m / SEQ;
        f32x4 v[4]; float s = 0.f;
#pragma unroll
        for (int j = 0; j < 4; ++j) { if constexpr (XB16) v[j] = (f32x4){bflo(nh[j].x), bfhi(nh[j].x), bflo(nh[j].y), bfhi(nh[j].y)}; else v[j] = nf[j]; }
        NORM_LOAD(m + NWAVES);
#pragma unroll
        for (int j = 0; j < 4; ++j) { s += (v[j].x * v[j].x + v[j].y * v[j].y) + (v[j].z * v[j].z + v[j].w * v[j].w); }
        const float rstd = 1.f / sqrtf(wave_sum(s) * (1.f / D) + EPS);
        const float* ab = ada_l + (size_t)b * ADA_N;
        f32x4 yv[4]; float amax = 0.f;
        u32x2* o8 = (u32x2*)((bf16*)H + (size_t)m * D) + F.lane; unsigned* o4 = (unsigned*)((unsigned char*)(F8O == 2 ? H2 : H) + (size_t)m * D) + F.lane;
        float lg[8];
#pragma unroll
        for (int e = 0; e < 8; ++e) lg[e] = 0.f;
#pragma unroll
        for (int j = 0; j < 4; ++j) { const int col = 256 * j + 4 * F.lane;
            const f32x4 g4 = *(const f32x4*)(gain + col), sc4 = *(const f32x4*)(ab + sc_chunk * D + col), sh4 = *(const f32x4*)(ab + sh_chunk * D + col);
            const f32x4 y = (v[j] * rstd * g4) * (sc4 + 1.f) + sh4; yv[j] = y; amax = fmaxf(fmaxf(amax, fmaxf(fabsf(y.x), fabsf(y.y))), fmaxf(fabsf(y.z), fabsf(y.w)));
            if constexpr (F8O != 1) { u32x2 w; w.x = pk2(y.x, y.y); w.y = pk2(y.z, y.w); o8[64 * j] = w; }
            if constexpr (MOE) {
#pragma unroll
                for (int c = 0; c < 4; ++c)
#pragma unroll
                    for (int e = 0; e < 8; ++e) lg[e] += y[c] * rw[4 * j + c][e]; } }
        if constexpr (F8O != 0) {
#pragma unroll
            for (int o = 1; o < 64; o <<= 1) amax = fmaxf(amax, __shfl_xor(amax, o));
            amax = fmaxf(amax, 1e-20f); const float qs = 127.f / amax;
#pragma unroll
            for (int j = 0; j < 4; ++j) o4[64 * j] = pk4_i8(yv[j].x * qs, yv[j].y * qs, yv[j].z * qs, yv[j].w * qs);
            if (F.lane == 0) rsv[m] = amax * (1.f / 127.f);
        }
        if constexpr (MOE) {
#pragma unroll
            for (int e = 0; e < 8; ++e) lg[e] = wave_sum(lg[e]);
            int e0 = 0; float v0 = lg[0];
#pragma unroll
            for (int e = 1; e < 8; ++e) if (lg[e] > v0) { v0 = lg[e]; e0 = e; }
            int e1 = -1; float v1 = 0.f;
#pragma unroll
            for (int e = 0; e < 8; ++e) if (e != e0 && (e1 < 0 || lg[e] > v1)) { v1 = lg[e]; e1 = e; }
            if (F.lane == 0) { const float w0 = 1.f / (1.f + __expf(v1 - v0));
                toke[2 * m] = e0; toke[2 * m + 1] = e1; tokw[2 * m] = w0; tokw[2 * m + 1] = 1.f - w0;
                lds_inc(&F.LC[LC_LH + e0]); lds_inc(&F.LC[LC_LH + 8 + e1]); }
        }
    }
    if constexpr (MOE) {
        __syncthreads();
        if (F.tid < 16) __hip_atomic_fetch_add(F.ctl + CW_MOE + F.tid * 64, F.LC[LC_LH + F.tid], RLX_AGENT);
    }
#undef NORM_LOAD
}
__device__ __forceinline__ void phase_moe_sort(Frame& F, const int* toke, const float* tokw, int* list, float* wl, const float* rs, float* rsl) {
    PHASE_ENTER(F);
    if (F.tid < 16) F.LC[LC_CNT + F.tid] = __hip_atomic_load(F.ctl + CW_MOE + F.tid * 64, RLX_AGENT);
    if (F.tid >= 64 && F.tid < 80) F.LC[LC_LH + F.tid - 64] = 0u;
    __syncthreads();
    if (F.tid < 2) { unsigned o = 0; for (int e = 0; e < 8; ++e) { F.LC[LC_TOFF + F.tid * 8 + e] = o; o += (F.LC[LC_CNT + F.tid * 8 + e] + 255u) >> 8; } F.LC[LC_TOT + F.tid] = o; }
    const int rows_per = (M + F.G - 1) / F.G, r0 = F.bx * rows_per, r1 = (r0 + rows_per < M) ? r0 + rows_per : M;
    int me[2] = {0, 0}, mr[2] = {0, 0};
    for (int base = r0; base < r1; base += NTHR) {
        const int m = base + F.tid;
        if (m < r1) { me[0] = toke[2 * m]; me[1] = toke[2 * m + 1];
            mr[0] = (int)lds_inc(&F.LC[LC_LH + me[0]]); mr[1] = (int)lds_inc(&F.LC[LC_LH + 8 + me[1]]); }
    }
    __syncthreads();
    if (F.tid < 16) F.LC[LC_BASE + F.tid] = __hip_atomic_fetch_add(F.ctl + CW_MOE + 1024 + F.tid * 64, F.LC[LC_LH + F.tid], RLX_AGENT);
    __syncthreads();
    { const int m = r0 + F.tid;
      if (m < r1) {
#pragma unroll
        for (int s = 0; s < 2; ++s) { const int row = (int)F.LC[LC_TOFF + s * 8 + me[s]] * 256 + (int)F.LC[LC_BASE + s * 8 + me[s]] + mr[s];
            list[s * MOE_ROWS + row] = m; wl[s * MOE_ROWS + row] = tokw[2 * m + s]; rsl[s * MOE_ROWS + row] = rs[m]; } } }
    if (F.bx < 16) { const int se = F.bx, s = se >> 3; const int cnt = (int)F.LC[LC_CNT + se], nt = (cnt + 255) >> 8, ro = (int)F.LC[LC_TOFF + se] * 256;
        for (int r = cnt + F.tid; r < nt * 256; r += NTHR) { list[s * MOE_ROWS + ro + r] = 0; wl[s * MOE_ROWS + ro + r] = 0.f; rsl[s * MOE_ROWS + ro + r] = 0.f; } }
    __syncthreads();
}

__device__ __forceinline__ void phase_qkprep(Frame& F, bf16* proj, const float* gq, const float* gk) {
    PHASE_ENTER(F);
    const int gw = F.vcu * NWAVES + F.wave, NGW = F.G * NWAVES;
    const int d0 = (F.lane & 7) * 8;
    float gqv[8], gkv[8];
#pragma unroll
    for (int i = 0; i < 8; ++i) { gqv[i] = gq[d0 + i] * (0.125f * LOG2E); gkv[i] = gk[d0 + i]; }
    for (int m = gw; m < M; m += NGW) {
#pragma unroll
        for (int which = 0; which < 2; ++which) {
            u32x4* p = (u32x4*)(proj + (size_t)m * DIN + (which ? C_DK : C_DQ)) + F.lane;
            const u32x4 w = *p; float v[8];
#pragma unroll
            for (int q = 0; q < 4; ++q) { v[2 * q] = bflo(w[q]); v[2 * q + 1] = bfhi(w[q]); }
            float s = 0.f;
#pragma unroll
            for (int i = 0; i < 8; ++i) s += v[i] * v[i];
            s += __shfl_xor(s, 1); s += __shfl_xor(s, 2); s += __shfl_xor(s, 4);
            const float rstd = 1.f / sqrtf(s * (1.f / 64.f) + EPS);
            u32x4 o;
#pragma unroll
            for (int q = 0; q < 4; ++q) o[q] = pk2(v[2 * q] * rstd * (which ? gkv[2 * q] : gqv[2 * q]), v[2 * q + 1] * rstd * (which ? gkv[2 * q + 1] : gqv[2 * q + 1]));
            *p = o;
        }
    }
}

__device__ __forceinline__ void phase_hgrn_naive(Frame& F, const bf16* proj, const float* lbv, const float* gn, bf16* ocat) {
    PHASE_ENTER(F);
    LAS float* Fs = (LAS float*)F.lds;
    LAS float* Ks = Fs + 2048; LAS float* Qs = Ks + 2048; LAS float* Vs = Qs + 2048; LAS float* Gs = Vs + 2048;
    LAS float* O4 = Gs + 2048;
    const int j = F.tid & 127, qr = F.tid >> 7;
    for (int it = F.bx; it < NB * 4; it += F.G) {
        const int b = it >> 2, h = it & 3;
        float S[32];
#pragma unroll
        for (int i = 0; i < 32; ++i) S[i] = 0.f;
        for (int t0 = 0; t0 < SEQ; t0 += 16) {
#pragma unroll
            for (int r = 0; r < 4; ++r) { const int idx = F.tid + NTHR * r, row = idx >> 7, col = idx & 127;
                const bf16* pr = proj + (size_t)(b * SEQ + t0 + row) * DIN + h * 128 + col;
                const float z = bf2f(pr[C_HF]), lb = lbv[h * 128 + col];
                Fs[idx] = lb + (1.f - lb) * sigm(z); Ks[idx] = (1.f - lb) * sigm(-z); Qs[idx] = bf2f(pr[C_HQ]); Vs[idx] = bf2f(pr[C_HI]); Gs[idx] = bf2f(pr[C_HG]); }
            __syncthreads();
            for (int tt = 0; tt < 16; ++tt) {
                const float v = Vs[tt * 128 + j]; float acc = 0.f;
#pragma unroll
                for (int i4 = 0; i4 < 8; ++i4) { const f32x4 f4 = *(const LAS f32x4*)(Fs + tt * 128 + qr * 32 + 4 * i4), k4 = *(const LAS f32x4*)(Ks + tt * 128 + qr * 32 + 4 * i4), q4 = *(const LAS f32x4*)(Qs + tt * 128 + qr * 32 + 4 * i4);
#pragma unroll
                    for (int c = 0; c < 4; ++c) { S[4 * i4 + c] = f4[c] * S[4 * i4 + c] + k4[c] * v; acc += S[4 * i4 + c] * q4[c]; } }
                O4[(qr * 16 + tt) * 128 + j] = acc;
            }
            __syncthreads();
#pragma unroll
            for (int rr = 0; rr < 2; ++rr) { const int tt = F.wave * 2 + rr;
                float o[2]; float ss = 0.f;
#pragma unroll
                for (int c = 0; c < 2; ++c) { const int jj = F.lane + 64 * c; o[c] = O4[(0 * 16 + tt) * 128 + jj] + O4[(1 * 16 + tt) * 128 + jj] + O4[(2 * 16 + tt) * 128 + jj] + O4[(3 * 16 + tt) * 128 + jj]; ss += o[c] * o[c]; }
                const float rstd = 1.f / sqrtf(wave_sum(ss) * (1.f / 128.f) + EPS);
#pragma unroll
                for (int c = 0; c < 2; ++c) { const int jj = F.lane + 64 * c; const float g = Gs[tt * 128 + jj];
                    ocat[(size_t)(b * SEQ + t0 + tt) * D + h * 128 + jj] = (bf16)f2bf(o[c] * rstd * gn[jj] * (g * sigm(g))); } }
            __syncthreads();
        }
    }
}

__device__ __forceinline__ void phase_attn_naive(Frame& F, const bf16* proj, bf16* tmp, const float* subg, float lam, float lam_init, bf16* ocat) {
    PHASE_ENTER(F);
    const int gw = F.vcu * NWAVES + F.wave, NGW = F.G * NWAVES;
    for (int it = gw; it < NB * 4 * (SEQ / 64); it += NGW) {
        const int qb = (SEQ / 64 - 1) - it / (NB * 4), bh = it % (NB * 4), b = bh >> 2, h = bh & 3;
        const int q = qb * 64 + F.lane; const size_t tok = (size_t)b * SEQ + q;
        const float slope2 = exp2f(-2.f * (float)(h + 1)) * LOG2E;
        for (int sub = 0; sub < 4; ++sub) {
            const int c = sub >> 1, vh = sub & 1;
            float qv[64], acc[64];
            { const u32x4* qp = (const u32x4*)(proj + tok * DIN + C_DQ + h * 128 + c * 64);
#pragma unroll
              for (int i = 0; i < 8; ++i) { const u32x4 w = qp[i];
#pragma unroll
                  for (int k = 0; k < 4; ++k) { qv[8 * i + 2 * k] = bflo(w[k]); qv[8 * i + 2 * k + 1] = bfhi(w[k]); } } }
#pragma unroll
            for (int i = 0; i < 64; ++i) acc[i] = 0.f;
            float mx = -INFINITY, l = 0.f;
            const int kend = qb * 64 + 63;
            for (int kk = 0; kk <= kend; ++kk) {
                const bf16* kr = proj + ((size_t)b * SEQ + kk) * DIN;
                const u32x4* kp = (const u32x4*)(kr + C_DK + h * 128 + c * 64);
                float s = 0.f;
#pragma unroll
                for (int i = 0; i < 8; ++i) { const u32x4 w = kp[i];
#pragma unroll
                    for (int k = 0; k < 4; ++k) { s += qv[8 * i + 2 * k] * bflo(w[k]); s += qv[8 * i + 2 * k + 1] * bfhi(w[k]); } }
                if (kk <= q) {
                    const float lg = s - slope2 * (float)(q - kk);
                    const float mn = fmaxf(mx, lg), al = exp2f(mx - mn), p = exp2f(lg - mn);
                    l = l * al + p; mx = mn;
                    const u32x4* vp = (const u32x4*)(kr + C_DV + h * 128 + vh * 64);
#pragma unroll
                    for (int i = 0; i < 8; ++i) { const u32x4 w = vp[i];
#pragma unroll
                        for (int k = 0; k < 4; ++k) { acc[8 * i + 2 * k] = acc[8 * i + 2 * k] * al + p * bflo(w[k]); acc[8 * i + 2 * k + 1] = acc[8 * i + 2 * k + 1] * al + p * bfhi(w[k]); } }
                }
            }
            const float rl = 1.f / l;
            u32x4* tp = (u32x4*)(tmp + ((tok * 4 + h) * 2 + c) * 128 + vh * 64);
#pragma unroll
            for (int i = 0; i < 8; ++i) { u32x4 w;
#pragma unroll
                for (int k = 0; k < 4; ++k) w[k] = pk2(acc[8 * i + 2 * k] * rl, acc[8 * i + 2 * k + 1] * rl);
                tp[i] = w; }
        }
        VM_WAIT();
        { const u32x4* t0 = (const u32x4*)(tmp + ((tok * 4 + h) * 2 + 0) * 128); const u32x4* t1 = (const u32x4*)(tmp + ((tok * 4 + h) * 2 + 1) * 128);
          float o[128]; float ss = 0.f;
#pragma unroll
          for (int i = 0; i < 16; ++i) { const u32x4 a = t0[i], bq = t1[i];
#pragma unroll
              for (int k = 0; k < 4; ++k) { o[8 * i + 2 * k] = bflo(a[k]) - lam * bflo(bq[k]); o[8 * i + 2 * k + 1] = bfhi(a[k]) - lam * bfhi(bq[k]); ss += o[8 * i + 2 * k] * o[8 * i + 2 * k] + o[8 * i + 2 * k + 1] * o[8 * i + 2 * k + 1]; } }
          const float sc = (1.f - lam_init) / sqrtf(ss * (1.f / 128.f) + EPS);
          u32x4* op = (u32x4*)(ocat + tok * D + 512 + h * 128);
#pragma unroll
          for (int i = 0; i < 16; ++i) { u32x4 w;
#pragma unroll
              for (int k = 0; k < 4; ++k) w[k] = pk2(o[8 * i + 2 * k] * sc * subg[8 * i + 2 * k], o[8 * i + 2 * k + 1] * sc * subg[8 * i + 2 * k + 1]);
              op[i] = w; } }
    }
}


__device__ __forceinline__ void phase_attn_prep(Frame& F, bf16* proj, const float* gq, const float* gk, unsigned char* kimg, unsigned char* vimg) {
    PHASE_ENTER(F);
    const int gw = F.vcu * NWAVES + F.wave, NGW = F.G * NWAVES;
    const int d0 = (F.lane & 7) * 8;
    float gqv[8], gkv[8];
#pragma unroll
    for (int i = 0; i < 8; ++i) { gqv[i] = gq[d0 + i] * (0.125f * LOG2E); gkv[i] = gk[d0 + i]; }
    u32x4 nx[2];
    if (gw < M) { nx[0] = *((const u32x4*)(proj + (size_t)gw * DIN + C_DQ) + F.lane); nx[1] = *((const u32x4*)(proj + (size_t)gw * DIN + C_DK) + F.lane); }
    for (int m = gw; m < M; m += NGW) {
        const int b = m / SEQ, pos = m % SEQ;
        const u32x4 cur0 = nx[0], cur1 = nx[1];
        if (m + NGW < M) { nx[0] = *((const u32x4*)(proj + (size_t)(m + NGW) * DIN + C_DQ) + F.lane); nx[1] = *((const u32x4*)(proj + (size_t)(m + NGW) * DIN + C_DK) + F.lane); }
#pragma unroll
        for (int which = 0; which < 2; ++which) {
            u32x4* p = (u32x4*)(proj + (size_t)m * DIN + (which ? C_DK : C_DQ)) + F.lane;
            const u32x4 w = which ? cur1 : cur0; float v[8];
#pragma unroll
            for (int q = 0; q < 4; ++q) { v[2 * q] = bflo(w[q]); v[2 * q + 1] = bfhi(w[q]); }
            float sq = 0.f;
#pragma unroll
            for (int i = 0; i < 8; ++i) sq += v[i] * v[i];
            sq += __shfl_xor(sq, 1); sq += __shfl_xor(sq, 2); sq += __shfl_xor(sq, 4);
            const float rstd = __builtin_amdgcn_rsqf(sq * (1.f / 64.f) + EPS);
            u32x4 o;
#pragma unroll
            for (int q = 0; q < 4; ++q) o[q] = pk2(v[2 * q] * rstd * (which ? gkv[2 * q] : gqv[2 * q]), v[2 * q + 1] * rstd * (which ? gkv[2 * q + 1] : gqv[2 * q + 1]));
            if (which == 0) *p = o;
            else { const int hc = F.lane >> 3;
                const int tile = pos >> 6, kvl = pos & 63, half = kvl >> 5, ks = d0 >> 4, hb = (d0 >> 3) & 1, l = (kvl & 31) + 32 * hb;
                *(u32x4*)(kimg + ((size_t)((b * 8 + hc) * 64 + tile)) * 8192 + (half * 4 + ks) * 1024 + l * 16) = o; }
        }
    }
    LAS unsigned char* vs = F.lds + F.wave * 16384;
    for (int it = gw; it < NB * 4 * 64; it += NGW) {
        const int bh = it >> 6, tile = it & 63, b = bh >> 2, h = bh & 3;
        const bf16* src = proj + (size_t)(b * SEQ + tile * 64) * DIN + C_DV + h * 128;
#pragma unroll
        for (int i = 0; i < 16; ++i) { const int row = 4 * i + (F.lane >> 4), ch = F.lane & 15;
            *(LAS u32x4*)(vs + row * 256 + ch * 16) = *(const u32x4*)(src + (size_t)row * DIN + ch * 8); }
        LDS_WAIT(); asm volatile("" ::: "memory");
        unsigned char* dst = vimg + (size_t)it * 16384 + F.lane * 16;
        const int dl = F.lane & 31, hh = F.lane >> 5;
#pragma unroll
        for (int f = 0; f < 16; ++f) { const int db = f >> 2, t2 = (f >> 1) & 1, sp = f & 1;
            const LAS bf16* col = (const LAS bf16*)vs + (32 * t2 + 16 * sp + 4 * hh) * 128 + 32 * db + dl;
            u32x4 o;
            o.x = (unsigned)col[0 * 128] | ((unsigned)col[1 * 128] << 16); o.y = (unsigned)col[2 * 128] | ((unsigned)col[3 * 128] << 16);
            o.z = (unsigned)col[8 * 128] | ((unsigned)col[9 * 128] << 16); o.w = (unsigned)col[10 * 128] | ((unsigned)col[11 * 128] << 16);
            *(u32x4*)(dst + f * 1024) = o; }
        LDS_WAIT(); asm volatile("" ::: "memory");
    }
}

typedef float f32x16 __attribute__((ext_vector_type(16)));
__device__ __forceinline__ bf16x8 pack8(float a0, float a1, float a2, float a3, float a4, float a5, float a6, float a7) {
    u32x4 w; w.x = pg8::cvt_pk_bf16(a0, a1); w.y = pg8::cvt_pk_bf16(a2, a3); w.z = pg8::cvt_pk_bf16(a4, a5); w.w = pg8::cvt_pk_bf16(a6, a7); return __builtin_bit_cast(bf16x8, w); }
__device__ __forceinline__ void phase_attn(Frame& F, const bf16* proj, const unsigned char* kimg, const unsigned char* vimg, const float* subg, const float* misc, const int* order, gu32* ticket, bf16* ocat) {
    PHASE_ENTER(F);
    const int lane = F.lane, wave = F.wave, hi = lane >> 5, l31 = lane & 31, cm = wave >> 2, wq = wave & 3;
    constexpr int VR0 = 65536;
#define ATT_LDSRD(dst, vaddr, off) asm volatile("ds_read_b128 %0, %1 offset:%2" : "=v"(dst) : "v"(vaddr), "i"(off))
#define ATT_LDSWAIT(dst, n) asm volatile("s_waitcnt lgkmcnt(%1)" : "+v"(dst) : "i"(n))
#define ATT_DMA(src, dstoff) __builtin_amdgcn_global_load_lds((const unsigned*)(src), (LAS unsigned*)(F.lds + (dstoff)), 16, 0, 0)
#define ATT_DMA_K(t, slot) do { const size_t o_ = (size_t)(t) * 8192 + wave * 1024 + lane * 16; ATT_DMA(kb0 + o_, (slot) * 16384 + wave * 1024); ATT_DMA(kb1 + o_, (slot) * 16384 + 8192 + wave * 1024); } while (0)
#define ATT_DMA_V(t, slot) do { const size_t o_ = (size_t)(t) * 16384 + wave * 1024 + lane * 16; ATT_DMA(vb + o_, VR0 + (slot) * 16384 + wave * 1024); ATT_DMA(vb + o_ + 8192, VR0 + (slot) * 16384 + 8192 + wave * 1024); } while (0)
    const float lam = misc[0], lam_init = misc[1], B2 = misc[2];
    if (F.tid == 0) F.LC[76] = __hip_atomic_fetch_add(ticket, 1u, RLX_AGENT);
    __syncthreads();
    for (;;) {
        const int tk = (int)F.LC[76]; if (tk >= 1024) break;
        unsigned tk_next = 0u; if (F.tid == 0) tk_next = __hip_atomic_fetch_add(ticket, 1u, RLX_AGENT);
        const int v = order[tk], bh = v >> 5, qb = v & 31, b = bh >> 2, h = bh & 3;
        const int q0 = qb * 128, NT = 2 * qb + 2, qpos = q0 + 32 * wq + l31;
        int TS = (q0 - (int)misc[3 + h]) >> 6; if (TS < 0) TS = 0;
        const unsigned char* kb0 = kimg + (size_t)((bh * 2 + 0) * 64) * 8192; const unsigned char* kb1 = kimg + (size_t)((bh * 2 + 1) * 64) * 8192;
        const unsigned char* vb = vimg + (size_t)(bh * 64) * 16384;
        bf16x8 qf[4];
        { const bf16* qp = proj + (size_t)(b * SEQ + qpos) * DIN + C_DQ + h * 128 + cm * 64 + 8 * hi;
#pragma unroll
          for (int ks = 0; ks < 4; ++ks) qf[ks] = *(const bf16x8*)(qp + 16 * ks); }
        const float slope2 = exp2f(-2.f * (float)(h + 1)) * LOG2E;
        const float cb = -slope2 * (float)qpos - B2 + slope2 * (float)(4 * hi);
        f32x16 O[4];
#pragma unroll
        for (int db = 0; db < 4; ++db)
#pragma unroll
            for (int r = 0; r < 16; ++r) O[db][r] = 0.f;
        opaque_acc(O[0]); opaque_acc(O[1]); opaque_acc(O[2]); opaque_acc(O[3]);
        float lsum = 0.f;
        f32x16 pC0, pC1, pN0, pN1;
#define ATT_QK(P0, P1, t, slot) do { const float base_ = cb + slope2 * (float)(64 * (t)); \
            _Pragma("unroll") for (int r = 0; r < 16; ++r) { P0[r] = fmaf(slope2, (float)((r & 3) + 8 * (r >> 2)), base_); P1[r] = fmaf(slope2, (float)(32 + (r & 3) + 8 * (r >> 2)), base_); } \
            if ((t) >= NT - 2) { _Pragma("unroll") for (int r = 0; r < 16; ++r) { const int kv_ = 64 * (t) + (r & 3) + 8 * (r >> 2) + 4 * hi; if (kv_ > qpos) P0[r] = -INFINITY; if (kv_ + 32 > qpos) P1[r] = -INFINITY; } } \
            const unsigned ka_ = (unsigned)(uintptr_t)(F.lds + (slot) * 16384 + cm * 8192 + lane * 16); bf16x8 kq_[4]; \
            ATT_LDSRD(kq_[0], ka_, 0); ATT_LDSRD(kq_[1], ka_, 4096); ATT_LDSRD(kq_[2], ka_, 1024); ATT_LDSRD(kq_[3], ka_, 5120); \
            ATT_LDSWAIT(kq_[0], 3); P0 = __builtin_amdgcn_mfma_f32_32x32x16_bf16(kq_[0], qf[0], P0, 0, 0, 0); ATT_LDSRD(kq_[0], ka_, 2048); \
            ATT_LDSWAIT(kq_[1], 3); P1 = __builtin_amdgcn_mfma_f32_32x32x16_bf16(kq_[1], qf[0], P1, 0, 0, 0); ATT_LDSRD(kq_[1], ka_, 6144); \
            ATT_LDSWAIT(kq_[2], 3); P0 = __builtin_amdgcn_mfma_f32_32x32x16_bf16(kq_[2], qf[1], P0, 0, 0, 0); ATT_LDSRD(kq_[2], ka_, 3072); \
            ATT_LDSWAIT(kq_[3], 3); P1 = __builtin_amdgcn_mfma_f32_32x32x16_bf16(kq_[3], qf[1], P1, 0, 0, 0); ATT_LDSRD(kq_[3], ka_, 7168); \
            ATT_LDSWAIT(kq_[0], 3); P0 = __builtin_amdgcn_mfma_f32_32x32x16_bf16(kq_[0], qf[2], P0, 0, 0, 0); \
            ATT_LDSWAIT(kq_[1], 2); P1 = __builtin_amdgcn_mfma_f32_32x32x16_bf16(kq_[1], qf[2], P1, 0, 0, 0); \
            ATT_LDSWAIT(kq_[2], 1); P0 = __builtin_amdgcn_mfma_f32_32x32x16_bf16(kq_[2], qf[3], P0, 0, 0, 0); \
            ATT_LDSWAIT(kq_[3], 0); P1 = __builtin_amdgcn_mfma_f32_32x32x16_bf16(kq_[3], qf[3], P1, 0, 0, 0); } while (0)
#define ATT_CL(x) ((x) < NT ? (x) : NT - 1)
        ATT_DMA_K(TS, 0); ATT_DMA_K(ATT_CL(TS + 1), 1); ATT_DMA_V(TS, 0); ATT_DMA_K(ATT_CL(TS + 2), 2); ATT_DMA_V(ATT_CL(TS + 1), 1); ATT_DMA_K(ATT_CL(TS + 3), 3); ATT_DMA_V(ATT_CL(TS + 2), 2);
        asm volatile("s_waitcnt vmcnt(12)" ::: "memory"); __builtin_amdgcn_s_barrier(); asm volatile("" ::: "memory");
        ATT_QK(pC0, pC1, TS, 0);
        for (int t = TS; t < NT; ++t) {
            const int ks1 = (t + 1 - TS) & 3, ks0 = (t - TS) & 3, vs0 = ks0, vs3 = (t + 3 - TS) & 3;
            asm volatile("s_waitcnt vmcnt(8)" ::: "memory"); __builtin_amdgcn_s_barrier(); asm volatile("" ::: "memory");
            { ATT_DMA_K(ATT_CL(t + 4), ks0); ATT_DMA_V(ATT_CL(t + 3), vs3); }
            if (cm == 0) { if (t + 1 < NT) ATT_QK(pN0, pN1, t + 1, ks1); }
            bf16x8 pk[2][2];
            { float sa = 0.f, sb = 0.f;
#pragma unroll
              for (int r = 0; r < 16; ++r) { pC0[r] = __builtin_amdgcn_exp2f(pC0[r]); pC1[r] = __builtin_amdgcn_exp2f(pC1[r]); sa += pC0[r]; sb += pC1[r]; }
              lsum += sa + sb;
              pk[0][0] = pack8(pC0[0], pC0[1], pC0[2], pC0[3], pC0[4], pC0[5], pC0[6], pC0[7]); pk[0][1] = pack8(pC0[8], pC0[9], pC0[10], pC0[11], pC0[12], pC0[13], pC0[14], pC0[15]);
              pk[1][0] = pack8(pC1[0], pC1[1], pC1[2], pC1[3], pC1[4], pC1[5], pC1[6], pC1[7]); pk[1][1] = pack8(pC1[8], pC1[9], pC1[10], pC1[11], pC1[12], pC1[13], pC1[14], pC1[15]); }
            { const unsigned va_ = (unsigned)(uintptr_t)(F.lds + VR0 + vs0 * 16384 + lane * 16);
              bf16x8 vfr[4];
              ATT_LDSRD(vfr[0], va_, 0); ATT_LDSRD(vfr[1], va_, 1024); ATT_LDSRD(vfr[2], va_, 2048); ATT_LDSRD(vfr[3], va_, 3072);
#define ATT_PV1(i, nwait) do { ATT_LDSWAIT(vfr[(i) & 3], nwait); O[(i) >> 2] = __builtin_amdgcn_mfma_f32_32x32x16_bf16(vfr[(i) & 3], pk[((i) >> 1) & 1][(i) & 1], O[(i) >> 2], 0, 0, 0); \
                  if ((i) + 4 < 16) ATT_LDSRD(vfr[(i) & 3], va_, ((i) + 4) * 1024); } while (0)
              ATT_PV1(0, 3); ATT_PV1(1, 3); ATT_PV1(2, 3); ATT_PV1(3, 3); ATT_PV1(4, 3); ATT_PV1(5, 3); ATT_PV1(6, 3); ATT_PV1(7, 3);
              ATT_PV1(8, 3); ATT_PV1(9, 3); ATT_PV1(10, 3); ATT_PV1(11, 3); ATT_PV1(12, 3); ATT_PV1(13, 2); ATT_PV1(14, 1); ATT_PV1(15, 0);
#undef ATT_PV1
            }
            if (cm == 1) { if (t + 1 < NT) ATT_QK(pN0, pN1, t + 1, ks1); }
            pC0 = pN0; pC1 = pN1;
        }
        lsum += __shfl_xor(lsum, 32);
        const float rl = 1.f / lsum;
        asm volatile("s_waitcnt vmcnt(0) lgkmcnt(0)" ::: "memory"); __builtin_amdgcn_s_barrier(); asm volatile("" ::: "memory");
        LAS float* comb = (LAS float*)F.lds + wq * 4096 + lane;
        if (cm == 1) {
#pragma unroll
            for (int db = 0; db < 4; ++db)
#pragma unroll
                for (int r = 0; r < 16; ++r) comb[(db * 16 + r) * 64] = O[db][r] * rl;
        }
        asm volatile("s_waitcnt lgkmcnt(0)" ::: "memory"); __builtin_amdgcn_s_barrier(); asm volatile("" ::: "memory");
        if (cm == 0) {
            float ss = 0.f;
#pragma unroll
            for (int db = 0; db < 4; ++db)
#pragma unroll
                for (int r = 0; r < 16; ++r) { const float o = O[db][r] * rl - lam * comb[(db * 16 + r) * 64]; O[db][r] = o; ss += o * o; }
            ss += __shfl_xor(ss, 32);
            const float sc = (1.f - lam_init) / sqrtf(ss * (1.f / 128.f) + EPS);
            bf16* op = ocat + (size_t)(b * SEQ + qpos) * D + 512 + h * 128 + 4 * hi;
#pragma unroll
            for (int db = 0; db < 4; ++db)
#pragma unroll
                for (int g = 0; g < 4; ++g) { const f32x4 sg = *(const f32x4*)(subg + 32 * db + 8 * g + 4 * hi);
                    u32x2 w; w.x = pk2(O[db][4 * g] * sc * sg[0], O[db][4 * g + 1] * sc * sg[1]); w.y = pk2(O[db][4 * g + 2] * sc * sg[2], O[db][4 * g + 3] * sc * sg[3]);
                    *(u32x2*)(op + 32 * db + 8 * g) = w; }
        }
        if (F.tid == 0) F.LC[76] = tk_next;
        asm volatile("s_waitcnt lgkmcnt(0)" ::: "memory"); __builtin_amdgcn_s_barrier(); asm volatile("" ::: "memory");
    }
#undef ATT_DMA
#undef ATT_CL
#undef ATT_LDSRD
#undef ATT_LDSWAIT
#undef ATT_DMA_K
#undef ATT_DMA_V
#undef ATT_QK
}


template <bool FULL>
__device__ __forceinline__ void phase_hgrn(Frame& F, const bf16* proj, const float* lbv, const float* gn, float* Limg, float* Dtot, bf16* ocat) {
    PHASE_ENTER(F);
    const int lane = F.lane, wave = F.wave, hi = lane >> 5, l31 = lane & 31, jb = wave & 3, tb = wave >> 2;
    const int ip = F.tid & 63, tq = wave;
    LAS unsigned char* Qp = F.lds;
    LAS unsigned char* Kp = F.lds + 17408;
    LAS unsigned char* KT = F.lds + 34816;
    LAS unsigned char* VT = F.lds + 53248;
    LAS float* GT = (LAS float*)(F.lds + 71680);
    LAS float* D1 = (LAS float*)(F.lds + 75776);
    LAS float* D2 = D1 + 128;
    LAS unsigned char* AT = F.lds + 76800;
    LAS float* SS = (LAS float*)(F.lds + 82944);
    for (int u = F.bx; u < NB * 4 * 8; u += F.G) {
        const int bh = u >> 3, seg = u & 7, b = bh >> 2, h = bh & 3;
        if (!FULL && seg == 7) continue;
        f32x16 S[4];
#pragma unroll
        for (int ib = 0; ib < 4; ++ib)
#pragma unroll
            for (int r = 0; r < 16; ++r) S[ib][r] = 0.f;
        if (FULL) {
            for (int g = 0; g < seg; ++g) { const int up = bh * 8 + g;
#pragma unroll
                for (int ib = 0; ib < 4; ++ib) { const float* lp = Limg + (size_t)up * 16384 + ((jb * 4 + ib) * 64 + lane) * 16; const float* dp = Dtot + up * 128 + 32 * ib + 4 * hi;
#pragma unroll
                    for (int q = 0; q < 4; ++q) { const f32x4 lv = *(const f32x4*)(lp + 4 * q), dv = *(const f32x4*)(dp + 8 * q);
#pragma unroll
                        for (int c = 0; c < 4; ++c) S[ib][4 * q + c] = S[ib][4 * q + c] * dv[c] + lv[c]; } } }
        }
        float dsum0 = 0.f, dsum1 = 0.f;
        const float lb0 = lbv[h * 128 + 2 * ip], lb1 = lbv[h * 128 + 2 * ip + 1];
        unsigned zz[8], vv[8], qq[8];
#define HG_LOAD_RAW(chn) do { const bf16* pr_ = proj + ((size_t)b * SEQ + seg * 512 + (chn) * 64 + 8 * tq) * DIN + h * 128 + 2 * ip; \
            _Pragma("unroll") for (int rr = 0; rr < 8; ++rr) { zz[rr] = *(const unsigned*)(pr_ + (size_t)rr * DIN + C_HF); vv[rr] = *(const unsigned*)(pr_ + (size_t)rr * DIN + C_HI); if (FULL) qq[rr] = *(const unsigned*)(pr_ + (size_t)rr * DIN + C_HQ); } } while (0)
        HG_LOAD_RAW(0);
        for (int ch = 0; ch < 8; ++ch) {
            const size_t tok0 = (size_t)b * SEQ + seg * 512 + ch * 64;
            u32x2 gate[4];
            if (FULL) { const bf16* gp = proj + (tok0 + 32 * tb + l31) * DIN + C_HG + h * 128 + 32 * jb + 4 * hi;
#pragma unroll
                for (int g = 0; g < 4; ++g) gate[g] = *(const u32x2*)(gp + 8 * g); }
            float cs0[8], cs1[8], kk0[8], kk1[8];
            { float c0 = 0.f, c1 = 0.f;
#pragma unroll
              for (int rr = 0; rr < 8; ++rr) { const float z0 = bflo(zz[rr]), z1 = bfhi(zz[rr]);
                  const float e0 = __expf(-z0), e1 = __expf(-z1), s0 = __builtin_amdgcn_rcpf(1.f + e0), s1 = __builtin_amdgcn_rcpf(1.f + e1);
                  c0 += __builtin_amdgcn_logf(lb0 + (1.f - lb0) * s0); c1 += __builtin_amdgcn_logf(lb1 + (1.f - lb1) * s1); cs0[rr] = c0; cs1[rr] = c1;
                  kk0[rr] = (1.f - lb0) * e0 * s0; kk1[rr] = (1.f - lb1) * e1 * s1; }
              GT[tq * 128 + 2 * ip] = c0; GT[tq * 128 + 2 * ip + 1] = c1; }
            __syncthreads();
            float pre0 = 0.f, pre1 = 0.f, rho0 = 0.f, rho1 = 0.f, tot0 = 0.f, tot1 = 0.f;
#pragma unroll
            for (int g = 0; g < 8; ++g) { const f32x2 gt = *(const LAS f32x2*)(GT + g * 128 + 2 * ip);
                if (g < tq) { pre0 += gt.x; pre1 += gt.y; } if (g < 4) { rho0 += gt.x; rho1 += gt.y; } tot0 += gt.x; tot1 += gt.y; }
            { u32x4 kt0, kt1, vt0, vt1;
#pragma unroll
              for (int rr = 0; rr < 8; rr += 2) {
                  float k0[2], k1[2];
#pragma unroll
                  for (int e = 0; e < 2; ++e) { const int r2 = rr + e; const float b0 = pre0 + cs0[r2], b1 = pre1 + cs1[r2];
                      k0[e] = kk0[r2] * __builtin_amdgcn_exp2f(rho0 - b0); k1[e] = kk1[r2] * __builtin_amdgcn_exp2f(rho1 - b1);
                      *(LAS unsigned*)(Kp + (8 * tq + r2) * 272 + 4 * ip) = pk2(k0[e], k1[e]);
                      if (FULL) { const float q0 = bflo(qq[r2]) * __builtin_amdgcn_exp2f(b0 - rho0), q1 = bfhi(qq[r2]) * __builtin_amdgcn_exp2f(b1 - rho1);
                          *(LAS unsigned*)(Qp + (8 * tq + r2) * 272 + 4 * ip) = pk2(q0, q1); } }
                  kt0[rr >> 1] = pk2(k0[0], k0[1]); kt1[rr >> 1] = pk2(k1[0], k1[1]);
                  vt0[rr >> 1] = (vv[rr] & 0xffffu) | (vv[rr + 1] << 16); vt1[rr >> 1] = (vv[rr] >> 16) | (vv[rr + 1] & 0xffff0000u); }
              *(LAS u32x4*)(KT + (2 * ip) * 144 + 16 * tq) = kt0; *(LAS u32x4*)(KT + (2 * ip + 1) * 144 + 16 * tq) = kt1;
              *(LAS u32x4*)(VT + (2 * ip) * 144 + 16 * tq) = vt0; *(LAS u32x4*)(VT + (2 * ip + 1) * 144 + 16 * tq) = vt1; }
            if (tq == 0) { D1[2 * ip] = __builtin_amdgcn_exp2f(rho0); D1[2 * ip + 1] = __builtin_amdgcn_exp2f(rho1); D2[2 * ip] = __builtin_amdgcn_exp2f(tot0 - rho0); D2[2 * ip + 1] = __builtin_amdgcn_exp2f(tot1 - rho1); }
            dsum0 += tot0; dsum1 += tot1;
            __syncthreads();
            if (ch < 7) HG_LOAD_RAW(ch + 1);
#pragma unroll
            for (int ib = 0; ib < 4; ++ib)
#pragma unroll
                for (int q = 0; q < 4; ++q) { const f32x4 dv = *(const LAS f32x4*)(D1 + 32 * ib + 8 * q + 4 * hi);
#pragma unroll
                    for (int c = 0; c < 4; ++c) S[ib][4 * q + c] *= dv[c]; }
            f32x16 Ot;
            if (FULL) {
#pragma unroll
                for (int r = 0; r < 16; ++r) Ot[r] = 0.f;
                opaque_acc(Ot);
#pragma unroll
                for (int ib = 0; ib < 4; ++ib)
#pragma unroll
                    for (int sp = 0; sp < 2; ++sp) { const bf16x8 a = pack8(S[ib][8 * sp], S[ib][8 * sp + 1], S[ib][8 * sp + 2], S[ib][8 * sp + 3], S[ib][8 * sp + 4], S[ib][8 * sp + 5], S[ib][8 * sp + 6], S[ib][8 * sp + 7]);
                        const LAS unsigned char* qp = Qp + (32 * tb + l31) * 272 + (32 * ib + 16 * sp + 4 * hi) * 2;
                        const u32x2 lo = *(const LAS u32x2*)qp, hi2 = *(const LAS u32x2*)(qp + 16);
                        const u32x4 bw = {lo.x, lo.y, hi2.x, hi2.y};
                        Ot = __builtin_amdgcn_mfma_f32_32x32x16_bf16(a, __builtin_bit_cast(bf16x8, bw), Ot, 0, 0, 0); }
                for (int sb = 0; sb <= tb; ++sb) {
                    f32x16 P;
#pragma unroll
                    for (int r = 0; r < 16; ++r) P[r] = 0.f;
                    opaque_acc(P);
#pragma unroll
                    for (int ks = 0; ks < 8; ++ks) { const bf16x8 a = *(const LAS bf16x8*)(Kp + (32 * sb + l31) * 272 + (16 * ks + 8 * hi) * 2), bq = *(const LAS bf16x8*)(Qp + (32 * tb + l31) * 272 + (16 * ks + 8 * hi) * 2);
                        P = __builtin_amdgcn_mfma_f32_32x32x16_bf16(a, bq, P, 0, 0, 0); }
                    if (sb == tb) {
#pragma unroll
                        for (int r = 0; r < 16; ++r) if ((r & 3) + 8 * (r >> 2) + 4 * hi > l31) P[r] = 0.f; }
                    else asm volatile("s_nop 15" : "+v"(P));
#pragma unroll
                    for (int sp = 0; sp < 2; ++sp) { const LAS unsigned char* vp = VT + (32 * jb + l31) * 144 + (32 * sb + 16 * sp + 4 * hi) * 2;
                        const u32x2 lo = *(const LAS u32x2*)vp, hi2 = *(const LAS u32x2*)(vp + 16);
                        const u32x4 aw = {lo.x, lo.y, hi2.x, hi2.y};
                        const bf16x8 bq = pack8(P[8 * sp], P[8 * sp + 1], P[8 * sp + 2], P[8 * sp + 3], P[8 * sp + 4], P[8 * sp + 5], P[8 * sp + 6], P[8 * sp + 7]);
                        Ot = __builtin_amdgcn_mfma_f32_32x32x16_bf16(__builtin_bit_cast(bf16x8, aw), bq, Ot, 0, 0, 0); } }
            }
#pragma unroll
            for (int ks = 0; ks < 4; ++ks) { const bf16x8 bv = *(const LAS bf16x8*)(VT + (32 * jb + l31) * 144 + (16 * ks + 8 * hi) * 2);
#pragma unroll
                for (int ib = 0; ib < 4; ++ib) { const bf16x8 a = *(const LAS bf16x8*)(KT + (32 * ib + l31) * 144 + (16 * ks + 8 * hi) * 2);
                    S[ib] = __builtin_amdgcn_mfma_f32_32x32x16_bf16(a, bv, S[ib], 0, 0, 0); } }
#pragma unroll
            for (int ib = 0; ib < 4; ++ib)
#pragma unroll
                for (int q = 0; q < 4; ++q) { const f32x4 dv = *(const LAS f32x4*)(D2 + 32 * ib + 8 * q + 4 * hi);
#pragma unroll
                    for (int c = 0; c < 4; ++c) S[ib][4 * q + c] *= dv[c]; }
            if (FULL) {
                float ss = 0.f;
#pragma unroll
                for (int r = 0; r < 16; ++r) ss += Ot[r] * Ot[r];
                ss += __shfl_xor(ss, 32);
                if (hi == 0) SS[jb * 64 + 32 * tb + l31] = ss;
                __syncthreads();
                const int t = 32 * tb + l31;
                const float rstd = 1.f / sqrtf((SS[t] + SS[64 + t] + SS[128 + t] + SS[192 + t]) * (1.f / 128.f) + EPS);
                bf16* op = ocat + (tok0 + t) * D + h * 128 + 32 * jb + 4 * hi;
#pragma unroll
                for (int g = 0; g < 4; ++g) { const f32x4 gv = *(const f32x4*)(gn + 32 * jb + 8 * g + 4 * hi);
                    const float g0 = bflo(gate[g].x), g1 = bfhi(gate[g].x), g2 = bflo(gate[g].y), g3 = bfhi(gate[g].y);
                    u32x2 w; w.x = pk2(Ot[4 * g] * rstd * gv[0] * (g0 * sigm(g0)), Ot[4 * g + 1] * rstd * gv[1] * (g1 * sigm(g1)));
                    w.y = pk2(Ot[4 * g + 2] * rstd * gv[2] * (g2 * sigm(g2)), Ot[4 * g + 3] * rstd * gv[3] * (g3 * sigm(g3)));
                    *(u32x2*)(op + 8 * g) = w; }
            }
        }
        if (!FULL) {
            if (tb == 0) {
#pragma unroll
                for (int ib = 0; ib < 4; ++ib) { float* lp = Limg + (size_t)u * 16384 + ((jb * 4 + ib) * 64 + lane) * 16;
#pragma unroll
                    for (int q = 0; q < 4; ++q) *(f32x4*)(lp + 4 * q) = (f32x4){S[ib][4 * q], S[ib][4 * q + 1], S[ib][4 * q + 2], S[ib][4 * q + 3]}; } }
            if (tq == 0) { Dtot[u * 128 + 2 * ip] = __builtin_amdgcn_exp2f(dsum0); Dtot[u * 128 + 2 * ip + 1] = __builtin_amdgcn_exp2f(dsum1); }
        }
        __syncthreads();
    }
#undef HG_LOAD_RAW
}


template <bool FULL>
__device__ __forceinline__ void phase_hgrn2(Frame& F, const bf16* proj, const float* lbv, const float* gn, float* Limg, float* Dtot, bf16* ocat) {
    PHASE_ENTER(F);
    const int lane = F.lane, wave = F.wave, hi = lane >> 5, l31 = lane & 31;
    constexpr int SETB = 72704, KPO = 17408, KTO = 34816, VTO = 53248, D1O = 71680, D2O = 72192, SSO = 2 * SETB;
    constexpr int NI = FULL ? 10 : 9;
    for (int u = F.bx; u < NB * 4 * 8; u += F.G) {
        const int bh = u >> 3, seg = u & 7, b = bh >> 2, h = bh & 3;
        if (!FULL && seg == 7) continue;
        const size_t tokS = (size_t)b * SEQ + seg * 512;
        if (wave >= 4) {
            const int pw = wave - 4, cg = lane & 15, rg = lane >> 4, col = 32 * pw + 2 * cg;
            const float lb0 = lbv[h * 128 + col], lb1 = lbv[h * 128 + col + 1];
            float dsum0 = 0.f, dsum1 = 0.f;
            unsigned zz[16], vv[16], qq[16];
#define HG2_LOAD_RAW(chn) do { const bf16* pr_ = proj + (tokS + (chn) * 64 + 16 * rg) * DIN + h * 128 + col; \
            _Pragma("unroll") for (int rr = 0; rr < 16; ++rr) { zz[rr] = *(const unsigned*)(pr_ + (size_t)rr * DIN + C_HF); vv[rr] = *(const unsigned*)(pr_ + (size_t)rr * DIN + C_HI); if (FULL) qq[rr] = *(const unsigned*)(pr_ + (size_t)rr * DIN + C_HQ); } } while (0)
            HG2_LOAD_RAW(0);
            for (int it = 0; it < NI; ++it) {
                if (it < 8) {
                    LAS unsigned char* sb_ = F.lds + (it & 1) * SETB;
                    float cs0[16], cs1[16], kk0[16], kk1[16]; unsigned vc[16], qc[16];
                    float c0 = 0.f, c1 = 0.f;
#pragma unroll
                    for (int rr = 0; rr < 16; ++rr) { const float z0 = bflo(zz[rr]), z1 = bfhi(zz[rr]);
                        const float e0 = __builtin_amdgcn_exp2f(-LOG2E * z0), e1 = __builtin_amdgcn_exp2f(-LOG2E * z1), s0 = __builtin_amdgcn_rcpf(1.f + e0), s1 = __builtin_amdgcn_rcpf(1.f + e1);
                        c0 += __builtin_amdgcn_logf(lb0 + (1.f - lb0) * s0); c1 += __builtin_amdgcn_logf(lb1 + (1.f - lb1) * s1); cs0[rr] = c0; cs1[rr] = c1;
                        kk0[rr] = (1.f - lb0) * e0 * s0; kk1[rr] = (1.f - lb1) * e1 * s1; vc[rr] = vv[rr]; if (FULL) qc[rr] = qq[rr]; }
                    if (it < 7) HG2_LOAD_RAW(it + 1);
                    float pre0 = 0.f, pre1 = 0.f, rho0 = 0.f, rho1 = 0.f, tot0 = 0.f, tot1 = 0.f;
#pragma unroll
                    for (int g = 0; g < 4; ++g) { const float t0 = __shfl(c0, cg + 16 * g), t1 = __shfl(c1, cg + 16 * g);
                        if (g < rg) { pre0 += t0; pre1 += t1; } if (g < 2) { rho0 += t0; rho1 += t1; } tot0 += t0; tot1 += t1; }
                    u32x4 kt0[2], kt1[2], vt0[2], vt1[2];
#pragma unroll
                    for (int rr = 0; rr < 16; rr += 2) { float k0[2], k1[2];
#pragma unroll
                        for (int e = 0; e < 2; ++e) { const int r2 = rr + e; const float b0 = pre0 + cs0[r2], b1 = pre1 + cs1[r2];
                            k0[e] = kk0[r2] * __builtin_amdgcn_exp2f(rho0 - b0); k1[e] = kk1[r2] * __builtin_amdgcn_exp2f(rho1 - b1);
                            *(LAS unsigned*)(sb_ + KPO + (16 * rg + r2) * 272 + 2 * col) = pk2(k0[e], k1[e]);
                            if (FULL) { const float q0 = bflo(qc[r2]) * __builtin_amdgcn_exp2f(b0 - rho0), q1 = bfhi(qc[r2]) * __builtin_amdgcn_exp2f(b1 - rho1);
                                *(LAS unsigned*)(sb_ + (16 * rg + r2) * 272 + 2 * col) = pk2(q0, q1); } }
                        kt0[rr >> 3][(rr >> 1) & 3] = pk2(k0[0], k0[1]); kt1[rr >> 3][(rr >> 1) & 3] = pk2(k1[0], k1[1]);
                        vt0[rr >> 3][(rr >> 1) & 3] = (vc[rr] & 0xffffu) | (vc[rr + 1] << 16); vt1[rr >> 3][(rr >> 1) & 3] = (vc[rr] >> 16) | (vc[rr + 1] & 0xffff0000u); }
#pragma unroll
                    for (int p = 0; p < 2; ++p) {
                        *(LAS u32x4*)(sb_ + KTO + col * 144 + 32 * rg + 16 * p) = kt0[p]; *(LAS u32x4*)(sb_ + KTO + (col + 1) * 144 + 32 * rg + 16 * p) = kt1[p];
                        *(LAS u32x4*)(sb_ + VTO + col * 144 + 32 * rg + 16 * p) = vt0[p]; *(LAS u32x4*)(sb_ + VTO + (col + 1) * 144 + 32 * rg + 16 * p) = vt1[p]; }
                    if (rg == 0) { *(LAS f32x2*)(sb_ + D1O + 4 * col) = (f32x2){__builtin_amdgcn_exp2f(rho0), __builtin_amdgcn_exp2f(rho1)};
                        *(LAS f32x2*)(sb_ + D2O + 4 * col) = (f32x2){__builtin_amdgcn_exp2f(tot0 - rho0), __builtin_amdgcn_exp2f(tot1 - rho1)}; }
                    dsum0 += tot0; dsum1 += tot1;
                }
                __syncthreads();
            }
            if (!FULL) { if (rg == 0) { Dtot[u * 128 + col] = __builtin_amdgcn_exp2f(dsum0); Dtot[u * 128 + col + 1] = __builtin_amdgcn_exp2f(dsum1); } }
#undef HG2_LOAD_RAW
        } else {
            const int jb = wave;
            f32x16 S[4];
#pragma unroll
            for (int ib = 0; ib < 4; ++ib)
#pragma unroll
                for (int r = 0; r < 16; ++r) S[ib][r] = 0.f;
            if (FULL) {
                for (int g = 0; g < seg; ++g) { const int up = bh * 8 + g;
#pragma unroll
                    for (int ib = 0; ib < 4; ++ib) { const float* lp = Limg + (size_t)up * 16384 + ((jb * 4 + ib) * 64 + lane) * 16; const float* dp = Dtot + up * 128 + 32 * ib + 4 * hi;
#pragma unroll
                        for (int q = 0; q < 4; ++q) { const f32x4 lv = *(const f32x4*)(lp + 4 * q), dv = *(const f32x4*)(dp + 8 * q);
#pragma unroll
                            for (int c = 0; c < 4; ++c) S[ib][4 * q + c] = S[ib][4 * q + c] * dv[c] + lv[c]; } } }
            }
            f32x16 OtP[2]; u32x2 gateP[2][4];
#pragma unroll
            for (int tb = 0; tb < 2; ++tb) {
#pragma unroll
                for (int r = 0; r < 16; ++r) OtP[tb][r] = 0.f;
#pragma unroll
                for (int g = 0; g < 4; ++g) gateP[tb][g] = (u32x2){0u, 0u}; }
            for (int it = 0; it < NI; ++it) {
                if (FULL && it >= 2) {
                    const LAS float* SSb = (const LAS float*)(F.lds + SSO) + ((it - 2) & 1) * 256; const size_t tok0 = tokS + (size_t)(it - 2) * 64;
#pragma unroll
                    for (int tb = 0; tb < 2; ++tb) { const int t = 32 * tb + l31;
                        const float rstd = __builtin_amdgcn_rsqf((SSb[t] + SSb[64 + t] + SSb[128 + t] + SSb[192 + t]) * (1.f / 128.f) + EPS);
                        bf16* op = ocat + (tok0 + t) * D + h * 128 + 32 * jb + 4 * hi;
#pragma unroll
                        for (int g = 0; g < 4; ++g) { const f32x4 gv = *(const f32x4*)(gn + 32 * jb + 8 * g + 4 * hi);
                            const float g0 = bflo(gateP[tb][g].x), g1 = bfhi(gateP[tb][g].x), g2 = bflo(gateP[tb][g].y), g3 = bfhi(gateP[tb][g].y);
                            u32x2 w; w.x = pk2(OtP[tb][4 * g] * rstd * gv[0] * (g0 * sigm(g0)), OtP[tb][4 * g + 1] * rstd * gv[1] * (g1 * sigm(g1)));
                            w.y = pk2(OtP[tb][4 * g + 2] * rstd * gv[2] * (g2 * sigm(g2)), OtP[tb][4 * g + 3] * rstd * gv[3] * (g3 * sigm(g3)));
                            *(u32x2*)(op + 8 * g) = w; } }
                }
                if (it >= 1 && it <= 8) {
                    const int ch = it - 1; const size_t tok0 = tokS + (size_t)ch * 64;
                    const LAS unsigned char* Qp = F.lds + (ch & 1) * SETB; const LAS unsigned char* Kp = Qp + KPO; const LAS unsigned char* KT = Qp + KTO; const LAS unsigned char* VT = Qp + VTO;
                    const LAS float* D1 = (const LAS float*)(Qp + D1O); const LAS float* D2 = (const LAS float*)(Qp + D2O);
                    u32x2 gateN[2][4];
                    if (FULL) {
#pragma unroll
                        for (int tb = 0; tb < 2; ++tb) { const bf16* gp = proj + (tok0 + 32 * tb + l31) * DIN + C_HG + h * 128 + 32 * jb + 4 * hi;
#pragma unroll
                            for (int g = 0; g < 4; ++g) gateN[tb][g] = *(const u32x2*)(gp + 8 * g); } }
#pragma unroll
                    for (int ib = 0; ib < 4; ++ib)
#pragma unroll
                        for (int q = 0; q < 4; ++q) { const f32x4 dv = *(const LAS f32x4*)(D1 + 32 * ib + 8 * q + 4 * hi);
#pragma unroll
                            for (int c = 0; c < 4; ++c) S[ib][4 * q + c] *= dv[c]; }
                    f32x16 Ot[2];
                    if (FULL) {
#pragma unroll
                        for (int tb = 0; tb < 2; ++tb)
#pragma unroll
                            for (int r = 0; r < 16; ++r) Ot[tb][r] = 0.f;
                        opaque_acc(Ot[0]); opaque_acc(Ot[1]);
#pragma unroll
                        for (int ib = 0; ib < 4; ++ib)
#pragma unroll
                            for (int sp = 0; sp < 2; ++sp) { const bf16x8 a = pack8(S[ib][8 * sp], S[ib][8 * sp + 1], S[ib][8 * sp + 2], S[ib][8 * sp + 3], S[ib][8 * sp + 4], S[ib][8 * sp + 5], S[ib][8 * sp + 6], S[ib][8 * sp + 7]);
#pragma unroll
                                for (int tb = 0; tb < 2; ++tb) { const LAS unsigned char* qp = Qp + (32 * tb + l31) * 272 + (32 * ib + 16 * sp + 4 * hi) * 2;
                                    const u32x2 lo = *(const LAS u32x2*)qp, hi2 = *(const LAS u32x2*)(qp + 16);
                                    const u32x4 bw = {lo.x, lo.y, hi2.x, hi2.y};
                                    Ot[tb] = __builtin_amdgcn_mfma_f32_32x32x16_bf16(a, __builtin_bit_cast(bf16x8, bw), Ot[tb], 0, 0, 0); } }
#pragma unroll
                        for (int tile = 0; tile < 3; ++tile) { const int sb = tile >> 1, tb = (tile + 1) >> 1;
                            f32x16 P;
#pragma unroll
                            for (int r = 0; r < 16; ++r) P[r] = 0.f;
                            opaque_acc(P);
#pragma unroll
                            for (int ks = 0; ks < 8; ++ks) { const bf16x8 a = *(const LAS bf16x8*)(Kp + (32 * sb + l31) * 272 + (16 * ks + 8 * hi) * 2), bq = *(const LAS bf16x8*)(Qp + (32 * tb + l31) * 272 + (16 * ks + 8 * hi) * 2);
                                P = __builtin_amdgcn_mfma_f32_32x32x16_bf16(a, bq, P, 0, 0, 0); }
                            if (sb == tb) {
#pragma unroll
                                for (int r = 0; r < 16; ++r) if ((r & 3) + 8 * (r >> 2) + 4 * hi > l31) P[r] = 0.f; }
                            else asm volatile("s_nop 15" : "+v"(P));
#pragma unroll
                            for (int sp = 0; sp < 2; ++sp) { const LAS unsigned char* vp = VT + (32 * jb + l31) * 144 + (32 * sb + 16 * sp + 4 * hi) * 2;
                                const u32x2 lo = *(const LAS u32x2*)vp, hi2 = *(const LAS u32x2*)(vp + 16);
                                const u32x4 aw = {lo.x, lo.y, hi2.x, hi2.y};
                                const bf16x8 bq = pack8(P[8 * sp], P[8 * sp + 1], P[8 * sp + 2], P[8 * sp + 3], P[8 * sp + 4], P[8 * sp + 5], P[8 * sp + 6], P[8 * sp + 7]);
                                Ot[tb] = __builtin_amdgcn_mfma_f32_32x32x16_bf16(__builtin_bit_cast(bf16x8, aw), bq, Ot[tb], 0, 0, 0); } }
                    }
#pragma unroll
                    for (int ks = 0; ks < 4; ++ks) { const bf16x8 bv = *(const LAS bf16x8*)(VT + (32 * jb + l31) * 144 + (16 * ks + 8 * hi) * 2);
#pragma unroll
                        for (int ib = 0; ib < 4; ++ib) { const bf16x8 a = *(const LAS bf16x8*)(KT + (32 * ib + l31) * 144 + (16 * ks + 8 * hi) * 2);
                            S[ib] = __builtin_amdgcn_mfma_f32_32x32x16_bf16(a, bv, S[ib], 0, 0, 0); } }
#pragma unroll
                    for (int ib = 0; ib < 4; ++ib)
#pragma unroll
                        for (int q = 0; q < 4; ++q) { const f32x4 dv = *(const LAS f32x4*)(D2 + 32 * ib + 8 * q + 4 * hi);
#pragma unroll
                            for (int c = 0; c < 4; ++c) S[ib][4 * q + c] *= dv[c]; }
                    if (FULL) {
                        LAS float* SSb = (LAS float*)(F.lds + SSO) + (ch & 1) * 256;
#pragma unroll
                        for (int tb = 0; tb < 2; ++tb) { float ss = 0.f;
#pragma unroll
                            for (int r = 0; r < 16; ++r) ss += Ot[tb][r] * Ot[tb][r];
                            ss += __shfl_xor(ss, 32);
                            if (hi == 0) SSb[jb * 64 + 32 * tb + l31] = ss;
                            OtP[tb] = Ot[tb];
#pragma unroll
                            for (int g = 0; g < 4; ++g) gateP[tb][g] = gateN[tb][g]; }
                    }
                }
                __syncthreads();
            }
            if (!FULL) {
#pragma unroll
                for (int ib = 0; ib < 4; ++ib) { float* lp = Limg + (size_t)u * 16384 + ((jb * 4 + ib) * 64 + lane) * 16;
#pragma unroll
                    for (int q = 0; q < 4; ++q) *(f32x4*)(lp + 4 * q) = (f32x4){S[ib][4 * q], S[ib][4 * q + 1], S[ib][4 * q + 2], S[ib][4 * q + 3]}; }
            }
        }
        __syncthreads();
    }
}

#ifndef REP_ATTN
#define REP_ATTN 1
#endif
#ifndef REP_HGRN
#define REP_HGRN 1
#endif
#ifndef REP_G1
#define REP_G1 1
#endif
#ifndef REP_MUP
#define REP_MUP 1
#endif
#ifndef REP_F1
#define REP_F1 1
#endif
#ifndef REP_PREP
#define REP_PREP 1
#endif
__global__ void __launch_bounds__(NTHR, 2) mega_fwd(Args args) {
    extern __shared__ __attribute__((aligned(16))) unsigned char lds[];
    Frame F;
    F.lds = (LAS unsigned char*)lds;
    F.LC = (volatile LAS unsigned*)(F.lds + LDSCTL_OFF);
    volatile LAS unsigned* MISC = (volatile LAS unsigned*)(F.lds + MISC_OFF);
    F.tid = threadIdx.x; F.lane = F.tid & 63; F.wave = __builtin_amdgcn_readfirstlane(F.tid >> 6);
    F.G = gridDim.x; { const int bx = blockIdx.x; F.vcu = (F.G % 8 == 0) ? (bx % 8) * (F.G / 8) + bx / 8 : bx; }
    F.ws = args.ws; F.ctl = (gu32*)(args.ws + WS_CTL); F.adaf = (float*)(args.ws + WS_ADA);
    for (int u = F.tid; u < (LDS_BYTES - LDSCTL_OFF) / 4; u += NTHR) ((LAS unsigned*)(F.lds + LDSCTL_OFF))[u] = 0u;
    __syncthreads();
    XcdBarrier bar = xcd_barrier_post((unsigned*)(F.ctl + CW_BAR), MISC + 8);
#define GRID_BAR() xcd_barrier(bar)
    unsigned char* ws = args.ws;
    F.bx = blockIdx.x;
    bf16* Hb = (bf16*)(ws + WS_H); bf16* OC = (bf16*)(ws + WS_OCAT); bf16* PROJ = (bf16*)(ws + WS_PROJ);
    float* xout = args.out; bf16* X16 = (bf16*)(ws + WS_X16);

    phase_prologue(F, args, 0);
    GRID_BAR();

    for (int l = 0; l < DEPTH; ++l) {
        const float* ada_l = F.adaf + AO_ADA + (size_t)l * NB * ADA_N;
        if (l == 0) phase_norm<false, 1, false>(F, args.in[0], args.in[4] + l * D, ada_l, 0, 1, ws + WS_H8, nullptr, F.adaf + AO_RS, nullptr, nullptr, nullptr);
        else phase_norm<false, 1, true>(F, X16, args.in[4] + l * D, ada_l, 0, 1, ws + WS_H8, nullptr, F.adaf + AO_RS, nullptr, nullptr, nullptr);
        GRID_BAR();
        { pg8::Gemm g{(const bf16*)(ws + WS_H8), (const bf16*)(ws + WS_WIN8 + (size_t)l * DIN * D), D / 2}; pg8::StaticOrder S; S.init(M, DIN, F.G, (int)blockIdx.x);
          pg8::EpiBf16<true> E{PROJ, DIN, QW_INV, F.adaf + AO_RS, C_GA / 256}; pg8::ADense AO;
          if (l == 0 && (blockIdx.x & 1)) { phase_prologue(F, args, 1); __syncthreads(); }
          for (int rep = 0; rep < REP_G1; ++rep) pg8::gemm_phase<pg8::EpiBf16<true>, pg8::StaticOrder, pg8::ADense, true, 2>(F.lds, g, S, AO, E);
          if (l == 0 && !(blockIdx.x & 1)) { __syncthreads(); phase_prologue(F, args, 1); } }
        GRID_BAR();
#ifdef NAIVE_ATTN
        phase_qkprep(F, PROJ, args.in[9] + l * 64, args.in[10] + l * 64);
#else
        phase_attn_prep(F, PROJ, args.in[9] + l * 64, args.in[10] + l * 64, ws + WS_KIMG, ws + WS_VIMG);
#endif
#ifndef NAIVE_HGRN
        __syncthreads();
        phase_hgrn2<false>(F, PROJ, F.adaf + AO_LB + l * 512, args.in[8] + l * 128, (float*)(ws + WS_HL), (float*)(ws + WS_HD), OC);
#endif
        GRID_BAR();
#ifdef NAIVE_HGRN
        phase_hgrn_naive(F, PROJ, F.adaf + AO_LB + l * 512, args.in[8] + l * 128, OC);
#else
        for (int rep = 0; rep < REP_HGRN; ++rep) phase_hgrn2<true>(F, PROJ, F.adaf + AO_LB + l * 512, args.in[8] + l * 128, (float*)(ws + WS_HL), (float*)(ws + WS_HD), OC);
#endif
#ifdef NAIVE_ATTN
        phase_attn_naive(F, PROJ, Hb, args.in[12] + l * 128, F.adaf[AO_MISC + l * 8 + 0], F.adaf[AO_MISC + l * 8 + 1], OC);
#else
        phase_attn(F, PROJ, ws + WS_KIMG, ws + WS_VIMG, args.in[12] + l * 128, F.adaf + AO_MISC + l * 8, (const int*)(F.adaf + AO_ORD) + l * 1024, F.ctl + CW_ATT + 64 * l, OC);
#endif
        GRID_BAR();
        { pg8::Gemm g{OC, (const bf16*)(ws + WS_WPAB) + (size_t)l * D * D, D}; pg8::StaticOrder S; S.init(M, D, F.G, (int)blockIdx.x);
          pg8::EpiMerge E{PROJ, Hb}; pg8::ADense AO;
          pg8::gemm_phase<pg8::EpiMerge, pg8::StaticOrder, pg8::ADense, true>(F.lds, g, S, AO, E); }
        GRID_BAR();
        { pg8::Gemm g{Hb, (const bf16*)(ws + WS_WO) + (size_t)l * D * D, D}; pg8::StaticOrder S; S.init(M, D, F.G, (int)blockIdx.x);
          pg8::ADense AO;
          if (l == 0) { pg8::EpiRes<true> E{args.in[0], X16, ada_l + 2 * D, 1.f}; pg8::gemm_phase<pg8::EpiRes<true>, pg8::StaticOrder, pg8::ADense, true>(F.lds, g, S, AO, E); }
          else {
              if (blockIdx.x & 1) { phase_moe_weights(F, args); __syncthreads(); }
              pg8::EpiRes<false> E{X16, X16, ada_l + 2 * D, 1.f}; pg8::gemm_phase<pg8::EpiRes<false>, pg8::StaticOrder, pg8::ADense, true>(F.lds, g, S, AO, E);
              if (!(blockIdx.x & 1)) { __syncthreads(); phase_moe_weights(F, args); } } }
        GRID_BAR();
        if (l == 0) {
            phase_norm<false, 1, true>(F, X16, args.in[5] + l * D, ada_l, 3, 4, Hb, nullptr, F.adaf + AO_RS, nullptr, nullptr, nullptr);
            GRID_BAR();
            { pg8::Gemm g{Hb, (const bf16*)(ws + WS_W13), D / 2}; pg8::StaticOrder S; S.init(M, 2 * DFF, F.G, (int)blockIdx.x);
              pg8::EpiSwiglu<false, true> E{(void*)(ws + WS_HID), DFF, 0, QW_INV, F.adaf + AO_RS, nullptr}; pg8::ADense AO;
              for (int rep = 0; rep < REP_F1; ++rep) pg8::gemm_phase<pg8::EpiSwiglu<false, true>, pg8::StaticOrder, pg8::ADense, true, 2>(F.lds, g, S, AO, E); }
            GRID_BAR();
            { pg8::Gemm g{(const bf16*)(ws + WS_HID), (const bf16*)(ws + WS_W2), DFF}; pg8::StaticOrder S; S.init(M, D, F.G, (int)blockIdx.x);
              pg8::EpiRes<false> E{X16, X16, ada_l + 5 * D, 1.f}; pg8::ADense AO;
              pg8::gemm_phase<pg8::EpiRes<false>, pg8::StaticOrder, pg8::ADense, true, 0>(F.lds, g, S, AO, E); }
            GRID_BAR();
        } else {
            int* toke = (int*)(ws + WS_TOKE); float* tokw = (float*)(ws + WS_TOKW); int* list = (int*)(ws + WS_LIST); float* wl = (float*)(ws + WS_WL);
#ifndef SKIP_NORMMOE
            phase_norm<true, 1, true>(F, X16, args.in[5] + l * D, ada_l, 3, 4, Hb, nullptr, F.adaf + AO_RS, args.in[19], toke, tokw);
#endif
            GRID_BAR();
            phase_moe_sort(F, toke, tokw, list, wl, F.adaf + AO_RS, (float*)(ws + WS_RSL));
            GRID_BAR();
            const int ndown = (int)F.LC[LC_TOT] * (D / 256), hv = ndown % F.G;
            for (int s = 0; s < 2; ++s) {
              for (int part = 0; part < 2; ++part) {
                if (s == 1 && part == (int)(blockIdx.x & 1)) { pg8::Gemm g{(const bf16*)(ws + WS_HIDM), (const bf16*)(ws + WS_MW2), DFFE / 2}; pg8::MoeOrder S{F.LC, 0, D / 256, F.G, (int)blockIdx.x}; pg8::ADense AO;
                    pg8::EpiMoeDown<false> E{X16, xout, ada_l + 5 * D, list, wl, W8_INV}; pg8::gemm_phase<pg8::EpiMoeDown<false>, pg8::MoeOrder, pg8::ADense, true, 1>(F.lds, g, S, AO, E); }
                if (part == 0) { pg8::Gemm g{Hb, (const bf16*)(ws + WS_MW13), D / 2}; pg8::MoeOrder S{F.LC, s, 2 * DFFE / 256, F.G, (int)blockIdx.x, s == 1 ? hv : 0, 3};
                  pg8::EpiSwiglu<true, true> E{(void*)(ws + WS_HIDM), DFFE, 2 * DFFE / 256, QW_INV, (const float*)(ws + WS_RSL), nullptr}; pg8::AGather AO{list};
                  for (int rep = 0; rep < REP_MUP; ++rep) pg8::gemm_phase<pg8::EpiSwiglu<true, true>, pg8::MoeOrder, pg8::AGather, true, 2>(F.lds, g, S, AO, E); }
              }
                GRID_BAR();
            }
            { pg8::Gemm g{(const bf16*)(ws + WS_HIDM), (const bf16*)(ws + WS_MW2), DFFE / 2}; pg8::MoeOrder S{F.LC, 1, D / 256, F.G, (int)blockIdx.x}; pg8::ADense AO;
              pg8::EpiMoeDown<true> E{X16, xout, ada_l + 5 * D, list, wl, W8_INV}; pg8::gemm_phase<pg8::EpiMoeDown<true>, pg8::MoeOrder, pg8::ADense, true, 1>(F.lds, g, S, AO, E); }
        }
    }
}

extern "C" void kernel_launch(void* const* d_in, const int* in_sizes, int n_in, void* d_out, int out_size, void* d_ws, size_t ws_size, hipStream_t stream) {
    static int grid = 0;
    if (grid == 0) {
        if (n_in != 23 || out_size != M * D || ws_size < WS_END) { fprintf(stderr, "kernel_launch: unexpected problem (n_in %d, out %d, ws %zu)\n", n_in, out_size, ws_size); grid = -1; return; }
        int dev = 0, cus = 0;
        if (hipGetDevice(&dev) != hipSuccess || hipDeviceGetAttribute(&cus, hipDeviceAttributeMultiprocessorCount, dev) != hipSuccess) { grid = -1; return; }
        if (hipFuncSetAttribute((const void*)mega_fwd, hipFuncAttributeMaxDynamicSharedMemorySize, LDS_BYTES) != hipSuccess) { fprintf(stderr, "kernel_launch: hipFuncSetAttribute failed\n"); grid = -1; return; }
        int per_cu = 0;
        if (hipOccupancyMaxActiveBlocksPerMultiprocessor(&per_cu, (const void*)mega_fwd, NTHR, LDS_BYTES) != hipSuccess || per_cu < 1) fprintf(stderr, "kernel_launch: occupancy query says %d\n", per_cu);
        (void)hipGetLastError();
        grid = cus;
    }
    if (grid < 0) return;
    if (hipMemsetAsync((char*)d_ws + WS_CTL, 0, CTL_ZERO_BYTES, stream) != hipSuccess) return;
    Args a{};
    for (int i = 0; i < 23; ++i) a.in[i] = (const float*)d_in[i];
    a.out = (float*)d_out; a.ws = (unsigned char*)d_ws;
    hipLaunchKernelGGL(mega_fwd, dim3(grid), dim3(NTHR), LDS_BYTES, stream, a);
}
```

```cpp
#include <hip/hip_runtime.h>
#include <cstdio>
#include <cstdint>

#define GAS __attribute__((address_space(1)))
#define LAS __attribute__((address_space(3)))
typedef unsigned short bf16;
typedef short bf16x8 __attribute__((ext_vector_type(8)));
typedef float f32x4 __attribute__((ext_vector_type(4)));
typedef float f32x2 __attribute__((ext_vector_type(2)));
typedef unsigned u32x4 __attribute__((ext_vector_type(4)));
typedef unsigned u32x2 __attribute__((ext_vector_type(2)));
typedef GAS unsigned gu32;

constexpr int NB = 8, SEQ = 4096, D = 1024, M = NB * SEQ, DEPTH = 2;
constexpr int DIN = 5632;
constexpr int C_HQ = 0, C_HF = 512, C_HI = 1024, C_HG = 1536, C_DQ = 2048, C_DK = 2560, C_DV = 3072, C_GA = 3584, C_GB = 4608;
constexpr int DFF = 2816, NEXP = 8, DFFE = 3584;
constexpr int ADA_N = 6 * D;
constexpr float EPS = 1e-6f;
constexpr float LOG2E = 1.4426950408889634f;
constexpr int NWAVES = 8, NTHR = 512;
constexpr int MOE_ROWS = 34816;

constexpr size_t MiB = 1u << 20;
constexpr size_t WS_CTL = 0, CTL_ZERO_BYTES = 1 * MiB;
constexpr size_t WS_ADA = 1 * MiB;
constexpr size_t WS_WIN8 = 2 * MiB;
constexpr size_t WS_WPAB = 13 * MiB;
constexpr size_t WS_WO = 17 * MiB;
constexpr size_t WS_W13 = 21 * MiB;
constexpr size_t WS_W2 = 26 * MiB + 512 * 1024;
constexpr size_t WS_H = 50 * MiB;
constexpr size_t WS_KIMG = 50 * MiB;
constexpr size_t WS_VIMG = 82 * MiB;
constexpr size_t WS_H8 = 114 * MiB;
constexpr size_t WS_OCAT = 114 * MiB;
constexpr size_t WS_PROJ = 178 * MiB;
constexpr size_t WS_HID = 178 * MiB;
constexpr size_t WS_MW13 = 178 * MiB;
constexpr size_t WS_MW2 = 234 * MiB;
constexpr size_t WS_HIDM = 262 * MiB;
constexpr size_t WS_HL = 32 * MiB;
constexpr size_t WS_HD = 48 * MiB;
constexpr size_t WS_X16 = 530 * MiB;
constexpr size_t WS_END = 594 * MiB;
constexpr size_t WS_TOKE = WS_OCAT;
constexpr size_t WS_TOKW = WS_OCAT + 1 * MiB;
constexpr size_t WS_LIST = WS_OCAT + 2 * MiB;
constexpr size_t WS_WL = WS_OCAT + 3 * MiB;
constexpr size_t WS_RSL = WS_OCAT + 4 * MiB;
constexpr int AO_ADA = 0, AO_LB = 2 * NB * ADA_N, AO_MISC = AO_LB + 2 * 512, AO_ORD = AO_MISC + 16, AO_RS = AO_ORD + 2048;
constexpr int CW_TMO = 0, CW_CODE = 1, CW_BAR = 4096, CW_MOE = 8192, CW_ATT = 12288;

constexpr int RING_BYTES = 131072, LDSCTL_OFF = 147456, MISC_OFF = LDSCTL_OFF + 320, LDS_BYTES = 163840;
constexpr int LC_CNT = 0, LC_TOFF = 16, LC_TOT = 32, LC_LH = 40, LC_BASE = 56;

#define RLX_AGENT __ATOMIC_RELAXED, __HIP_MEMORY_SCOPE_AGENT
#define LDS_WAIT() asm volatile("s_waitcnt lgkmcnt(0)" ::: "memory")
#define VM_WAIT() asm volatile("s_waitcnt vmcnt(0)" ::: "memory")

__device__ __forceinline__ unsigned f2bf(float f) { unsigned u = __builtin_bit_cast(unsigned, f); return (u + 0x7fffu + ((u >> 16) & 1u)) >> 16; }
__device__ __forceinline__ unsigned pk2(float lo, float hi) { unsigned r; asm("v_cvt_pk_bf16_f32 %0, %1, %2" : "=v"(r) : "v"(lo), "v"(hi)); return r; }
__device__ __forceinline__ float bflo(unsigned w) { return __uint_as_float(w << 16); }
__device__ __forceinline__ float bfhi(unsigned w) { return __uint_as_float(w & 0xffff0000u); }
__device__ __forceinline__ float bf2f(bf16 v) { return __uint_as_float((unsigned)v << 16); }
__device__ __forceinline__ unsigned pk4_fp8(float a, float b, float c, float d) { unsigned w = 0; w = __builtin_amdgcn_cvt_pk_fp8_f32(a, b, w, false); w = __builtin_amdgcn_cvt_pk_fp8_f32(c, d, w, true); return w; }
constexpr float QW_SCALE = 720.f, QW_INV = 1.f / QW_SCALE;
__device__ __forceinline__ unsigned q8(float x) { return (unsigned)(int)rintf(fminf(fmaxf(x, -127.f), 127.f)) & 0xffu; }
__device__ __forceinline__ unsigned pk4_i8(float a, float b, float c, float d) { return q8(a) | (q8(b) << 8) | (q8(c) << 16) | (q8(d) << 24); }
constexpr float W8_SCALE = 64.f, W8_INV = 1.f / 64.f;
__device__ __forceinline__ float sigm(float x) { return __builtin_amdgcn_rcpf(1.f + __builtin_amdgcn_exp2f(-LOG2E * x)); }
typedef float f32x16_ __attribute__((ext_vector_type(16)));
__device__ __forceinline__ void opaque_acc(f32x16_& v) { asm volatile("" : "+v"(v)); }
__device__ __forceinline__ unsigned lds_inc(volatile LAS unsigned* p) { return __hip_atomic_fetch_add((LAS unsigned*)p, 1u, __ATOMIC_RELAXED, __HIP_MEMORY_SCOPE_WORKGROUP); }
#define DPP_F(v, ctrl) __builtin_bit_cast(float, __builtin_amdgcn_mov_dpp(__builtin_bit_cast(int, v), ctrl, 0xf, 0xf, true))
#define RDL_F(v, l) __builtin_bit_cast(float, __builtin_amdgcn_readlane(__builtin_bit_cast(int, v), l))
__device__ __forceinline__ float wave_sum(float v) {
    v += DPP_F(v, 0x128); v += DPP_F(v, 0x124); v += DPP_F(v, 0x122); v += DPP_F(v, 0x121);
    return (RDL_F(v, 0) + RDL_F(v, 16)) + (RDL_F(v, 32) + RDL_F(v, 48));
}
__device__ __forceinline__ float wave_max(float v) {
    v = fmaxf(v, DPP_F(v, 0x128)); v = fmaxf(v, DPP_F(v, 0x124)); v = fmaxf(v, DPP_F(v, 0x122)); v = fmaxf(v, DPP_F(v, 0x121));
    return fmaxf(fmaxf(RDL_F(v, 0), RDL_F(v, 16)), fmaxf(RDL_F(v, 32), RDL_F(v, 48)));
}

namespace pg8 {
constexpr int BM = 256, BK = 64, HALF = 128, HTB = HALF * BK * 2, STAGE_BYTES = 8 * HTB, NXCD = 8, WGM = 8;
__host__ __device__ __forceinline__ int lds_byte(int r, int c) { const int st = (r >> 4) * 2 + (c >> 5), rr = r & 15, cc = c & 31, ob = rr * 64 + cc * 2; return st * 1024 + (ob ^ (((ob >> 9) & 1) << 5)); }
__host__ __device__ __forceinline__ void stage_rc(int b, int& R, int& C) { const int st = b / 1024, sb = b % 1024, swz = sb ^ (((sb >> 9) & 1) << 5); R = (st >> 1) * 16 + swz / 64; C = (st & 1) * 32 + (swz % 64) / 2; }
__host__ __device__ __forceinline__ int perm32(int rho) { const int n = rho >> 4, i = rho & 15; return 8 * (i >> 2) + 4 * n + (i & 3); }

struct Unit { int pm, pn, e, nvalid; };
struct Gemm { const bf16* A; const bf16* Bt; int K; };

struct StaticOrder {
    int nM, nN, nwg, G, c, rm0, rm1;
    __device__ void init(int M_, int N_, int G_, int c_, int rm0_ = 0, int rm1_ = 0) { nM = M_ / BM; nN = N_ / BM; nwg = nM * nN; G = G_; c = c_; rm0 = rm0_; rm1 = rm1_; }
    __device__ bool next(int i, Unit& u) const {
        const long L = (long)i * G + c; if (L >= nwg) return false;
        int wgid = (int)L; { const int q = nwg / NXCD, r = nwg % NXCD, xcd = wgid % NXCD, off = wgid / NXCD; wgid = (xcd < r ? xcd * (q + 1) : r * (q + 1) + (xcd - r) * q) + off; }
        const int nig = WGM * nN, gid = wgid / nig, fm = gid * WGM, gsz = (nM - fm) < WGM ? (nM - fm) : WGM;
        const int wi = wgid % nig; if (gsz == WGM) { u.pm = fm + (wi & (WGM - 1)); u.pn = wi / WGM; } else { u.pm = fm + (wi % gsz); u.pn = wi / gsz; }
        u.pn += u.pn < 4 ? rm0 : rm1; u.e = 0; u.nvalid = 256; return true;
    }
};
struct MoeOrder {
    const volatile LAS unsigned* lc; int s, nN, G, c; int hv = 0, skipr = 0, lo = 0, cnt = 1 << 20;
    __device__ bool next(int i, Unit& u) const {
        const int T0 = (int)lc[LC_TOT], T1 = (int)lc[LC_TOT + 1]; int T = s == 2 ? T0 + T1 : (s == 0 ? T0 : T1);
        if (s != 2) { T -= lo; if (T > cnt) T = cnt; if (T < 0) T = 0; }
        const int nwg = __builtin_amdgcn_readfirstlane(T * nN); long L;
        if (c < hv) { L = (long)(i + skipr) * G + c; if (L >= (long)nwg) return false; }
        else { L = (long)i * G + c;
            if (L >= (long)nwg) { if (hv == 0) return false;
                const int nreg = c < nwg ? (nwg - c + G - 1) / G : 0, m = (c - hv) + (i - nreg) * (G - hv); if (m >= skipr * hv) return false;
                L = (long)(m / hv) * G + (m % hv); if (L >= (long)nwg) return false; } }
        int wgid = (int)L; { const int q = nwg / NXCD, r = nwg % NXCD, xcd = wgid % NXCD, off = wgid / NXCD; wgid = (xcd < r ? xcd * (q + 1) : r * (q + 1) + (xcd - r) * q) + off; }
        const int nig = WGM * nN, gid = wgid / nig, fm = gid * WGM, gsz = (T - fm) < WGM ? (T - fm) : WGM;
        const int wi = wgid % nig; int rt, pnl; if (gsz == WGM) { rt = fm + (wi & (WGM - 1)); pnl = wi / WGM; } else { rt = fm + (wi % gsz); pnl = wi / gsz; } int sl = s;
        if (s == 2) { sl = rt >= T0 ? 1 : 0; rt -= sl * T0; } else rt += lo;
        int e = 0;
#pragma unroll
        for (int k = 1; k < NEXP; ++k) if ((int)lc[LC_TOFF + sl * 8 + k] <= rt) e = k;
        const int left = (int)lc[LC_CNT + sl * 8 + e] - (rt - (int)lc[LC_TOFF + sl * 8 + e]) * 256;
        u.pm = __builtin_amdgcn_readfirstlane(sl * (MOE_ROWS / 256) + rt); u.pn = __builtin_amdgcn_readfirstlane(e * nN + pnl); u.e = __builtin_amdgcn_readfirstlane(e);
        u.nvalid = __builtin_amdgcn_readfirstlane(left < 256 ? left : 256); return true;
    }
};
struct ADense { static constexpr bool GATHER = false; __device__ __forceinline__ void get(const Unit&, int, int, unsigned (&)[2][2]) const {}
    __device__ __forceinline__ void rows(const Unit&, int, int (&)[2][2]) const {} __device__ __forceinline__ void offs(const int (&)[2][2], int, int, unsigned (&)[2][2]) const {} };
struct AGather { static constexpr bool GATHER = true; const int* list;
    __device__ __forceinline__ void rows(const Unit& u, int tid, int (&row)[2][2]) const {
#pragma unroll
        for (int i = 0; i < 2; ++i) { int R, C; stage_rc(tid * 16 + i * 8192, R, C);
#pragma unroll
            for (int h = 0; h < 2; ++h) row[h][i] = list[u.pm * BM + h * HALF + R]; } }
    __device__ __forceinline__ void offs(const int (&row)[2][2], int tid, int K, unsigned (&off)[2][2]) const {
#pragma unroll
        for (int i = 0; i < 2; ++i) { int R, C; stage_rc(tid * 16 + i * 8192, R, C);
#pragma unroll
            for (int h = 0; h < 2; ++h) off[h][i] = (unsigned)((row[h][i] * K + C) * 2); } }
    __device__ __forceinline__ void get(const Unit& u, int tid, int K, unsigned (&off)[2][2]) const { int row[2][2]; rows(u, tid, row); offs(row, tid, K, off); } };

__device__ __forceinline__ unsigned cvt_pk_bf16(float lo, float hi) { unsigned r; asm volatile("v_cvt_pk_bf16_f32 %0, %1, %2" : "=v"(r) : "v"(lo), "v"(hi)); return r; }

typedef f32x4 Acc[2][2][4][2];
typedef int v8i __attribute__((ext_vector_type(8)));
typedef int v4i __attribute__((ext_vector_type(4)));
__device__ __forceinline__ f32x4 acc_i2f(f32x4 v) { const v4i i = __builtin_bit_cast(v4i, v); return (f32x4){(float)i.x, (float)i.y, (float)i.z, (float)i.w}; }
typedef short bf16x16 __attribute__((ext_vector_type(16)));

constexpr int IMAGIC = 0x4B400000; constexpr float FMAGIC = 12582912.f;
template <bool AI = false> struct EpiBf16 {
    static constexpr bool PERM = true; static constexpr int MID_T = 0; static constexpr bool HAS_PRE = true; static constexpr bool MAGIC = AI;
    bf16* O; int ldc; float asc; const float* rs; int sig_from = 1 << 30;
    __device__ __forceinline__ void mid(Acc&, const Unit&, int, int, int, int) const {}
    __device__ __forceinline__ void prefetch(const Unit& u, int wr, int fr, float (&p)[8]) const {
        if (rs) {
#pragma unroll
            for (int i = 0; i < 8; ++i) p[i] = rs[u.pm * BM + wr * 64 + fr + (i >> 2) * HALF + (i & 3) * 16]; } }
    __device__ __forceinline__ void operator()(const Acc& acc, const Unit& u, int wr, int wc, int fr, int fq, const float* pre = nullptr) const {
        const int row0 = u.pm * BM + wr * 64 + fr, col0 = u.pn * BM + wc * 32 + 8 * fq;
#pragma unroll
        for (int ai = 0; ai < 2; ++ai)
#pragma unroll
            for (int m = 0; m < 4; ++m) { bf16* rowp = O + (size_t)(row0 + ai * HALF + m * 16) * ldc + col0; const float sc = rs ? asc * (pre ? pre[ai * 4 + m] : rs[row0 + ai * HALF + m * 16]) : asc; const float nb = AI ? -FMAGIC * sc : 0.f;
#pragma unroll
                for (int bj = 0; bj < 2; ++bj) { const f32x4 v0 = AI ? __builtin_elementwise_fma(acc[ai][bj][m][0], (f32x4){sc, sc, sc, sc}, (f32x4){nb, nb, nb, nb}) : acc[ai][bj][m][0] * sc, v1 = AI ? __builtin_elementwise_fma(acc[ai][bj][m][1], (f32x4){sc, sc, sc, sc}, (f32x4){nb, nb, nb, nb}) : acc[ai][bj][m][1] * sc;
                    f32x4 s0 = v0, s1 = v1;
                    if (u.pn >= sig_from) {
                        const float sc2 = -LOG2E * sc, nb2 = -LOG2E * nb;
                        const f32x4 t0 = AI ? __builtin_elementwise_fma(acc[ai][bj][m][0], (f32x4){sc2, sc2, sc2, sc2}, (f32x4){nb2, nb2, nb2, nb2}) : acc[ai][bj][m][0] * sc2, t1 = AI ? __builtin_elementwise_fma(acc[ai][bj][m][1], (f32x4){sc2, sc2, sc2, sc2}, (f32x4){nb2, nb2, nb2, nb2}) : acc[ai][bj][m][1] * sc2;
                        const f32x4 d0 = (f32x4){__builtin_amdgcn_exp2f(t0[0]), __builtin_amdgcn_exp2f(t0[1]), __builtin_amdgcn_exp2f(t0[2]), __builtin_amdgcn_exp2f(t0[3])} + 1.f, d1 = (f32x4){__builtin_amdgcn_exp2f(t1[0]), __builtin_amdgcn_exp2f(t1[1]), __builtin_amdgcn_exp2f(t1[2]), __builtin_amdgcn_exp2f(t1[3])} + 1.f;
                        s0 = (f32x4){__builtin_amdgcn_rcpf(d0[0]), __builtin_amdgcn_rcpf(d0[1]), __builtin_amdgcn_rcpf(d0[2]), __builtin_amdgcn_rcpf(d0[3])}; s1 = (f32x4){__builtin_amdgcn_rcpf(d1[0]), __builtin_amdgcn_rcpf(d1[1]), __builtin_amdgcn_rcpf(d1[2]), __builtin_amdgcn_rcpf(d1[3])}; }
                    u32x4 w; w.x = cvt_pk_bf16(s0[0], s0[1]); w.y = cvt_pk_bf16(s0[2], s0[3]); w.z = cvt_pk_bf16(s1[0], s1[1]); w.w = cvt_pk_bf16(s1[2], s1[3]);
                    __builtin_nontemporal_store(w, (u32x4*)(rowp + bj * HALF)); } }
    }
};
struct EpiMerge {
    static constexpr bool PERM = true; static constexpr int MID_T = 8; static constexpr bool HAS_PRE = false; static constexpr bool MAGIC = false;
    const bf16* proj; bf16* Y;
    __device__ __forceinline__ void mid(Acc& acc, const Unit& u, int wr, int wc, int fr, int fq) const {
        int row0 = u.pm * BM + wr * 64 + fr, col0 = u.pn * BM + wc * 32 + 8 * fq;
        asm volatile("" : "+v"(row0), "+v"(col0));
        u32x4 ga[4][2], gb[4][2];
#define MG_LOAD(g, buf) do { const bf16* rp_ = proj + (size_t)(row0 + ((g) >> 2) * HALF + ((g) & 3) * 16) * DIN + col0; \
            ga[buf][0] = *(const u32x4*)(rp_ + C_GA); ga[buf][1] = *(const u32x4*)(rp_ + C_GA + HALF); gb[buf][0] = *(const u32x4*)(rp_ + C_GB); gb[buf][1] = *(const u32x4*)(rp_ + C_GB + HALF); } while (0)
        MG_LOAD(0, 0); MG_LOAD(1, 1); MG_LOAD(2, 2);
#pragma unroll
        for (int g = 0; g < 8; ++g) { const int ai = g >> 2, m = g & 3, cur = g & 3;
            if (g < 5) MG_LOAD(g + 3, (g + 3) & 3);
            asm volatile("" ::: "memory");
#pragma unroll
            for (int bj = 0; bj < 2; ++bj) { const u32x4 a = ga[cur][bj], b = gb[cur][bj]; float r[8];
#pragma unroll
                for (int q = 0; q < 4; ++q) { r[2 * q] = bflo(a[q]) * __builtin_amdgcn_rcpf(bflo(b[q])); r[2 * q + 1] = bfhi(a[q]) * __builtin_amdgcn_rcpf(bfhi(b[q])); }
                acc[ai][bj][m][0] = acc[ai][bj][m][0] * (f32x4){r[0], r[1], r[2], r[3]}; acc[ai][bj][m][1] = acc[ai][bj][m][1] * (f32x4){r[4], r[5], r[6], r[7]}; }
            asm volatile("" : "+v"(acc[ai][0][m][0]), "+v"(acc[ai][0][m][1]), "+v"(acc[ai][1][m][0]), "+v"(acc[ai][1][m][1]) :: "memory"); }
#undef MG_LOAD
    }
    __device__ __forceinline__ void operator()(const Acc& acc, const Unit& u, int wr, int wc, int fr, int fq) const {
        const int row0 = u.pm * BM + wr * 64 + fr, col0 = u.pn * BM + wc * 32 + 8 * fq;
#pragma unroll
        for (int ai = 0; ai < 2; ++ai)
#pragma unroll
            for (int m = 0; m < 4; ++m) { const size_t row = (size_t)(row0 + ai * HALF + m * 16);
#pragma unroll
                for (int bj = 0; bj < 2; ++bj) { const u32x4 b = *(const u32x4*)(proj + row * DIN + C_GB + col0 + bj * HALF);
                    const f32x4 v0 = acc[ai][bj][m][0], v1 = acc[ai][bj][m][1];
                    u32x4 w; w.x = cvt_pk_bf16(v0[0] * bflo(b.x), v0[1] * bfhi(b.x)); w.y = cvt_pk_bf16(v0[2] * bflo(b.y), v0[3] * bfhi(b.y));
                    w.z = cvt_pk_bf16(v1[0] * bflo(b.z), v1[1] * bfhi(b.z)); w.w = cvt_pk_bf16(v1[2] * bflo(b.w), v1[3] * bfhi(b.w));
                    *(u32x4*)(Y + row * D + col0 + bj * HALF) = w; } }
    }
};
template <bool BF32> struct EpiRes {
    static constexpr bool PERM = true; static constexpr int MID_T = 0; static constexpr bool HAS_PRE = false; static constexpr bool MAGIC = false;
    const void* base; bf16* out; const float* gate; float asc;
    __device__ __forceinline__ void mid(Acc&, const Unit&, int, int, int, int) const {}
    __device__ __forceinline__ void operator()(const Acc& acc, const Unit& u, int wr, int wc, int fr, int fq) const {
        const int b = (u.pm * BM) / SEQ, col0 = u.pn * BM + wc * 32 + 8 * fq;
        f32x4 gv[2][2];
#pragma unroll
        for (int bj = 0; bj < 2; ++bj)
#pragma unroll
            for (int n = 0; n < 2; ++n) gv[bj][n] = *(const f32x4*)(gate + (size_t)b * ADA_N + col0 + bj * HALF + n * 4) * asc;
#pragma unroll
        for (int ai = 0; ai < 2; ++ai)
#pragma unroll
            for (int m = 0; m < 4; ++m) { const size_t off = (size_t)(u.pm * BM + ai * HALF + wr * 64 + m * 16 + fr) * D + col0;
#pragma unroll
                for (int bj = 0; bj < 2; ++bj) { f32x4 bs0, bs1;
                    if constexpr (BF32) { bs0 = *(const f32x4*)((const float*)base + off + bj * HALF); bs1 = *(const f32x4*)((const float*)base + off + bj * HALF + 4); }
                    else { const u32x4 w = *(const u32x4*)((const bf16*)base + off + bj * HALF); bs0 = (f32x4){bflo(w.x), bfhi(w.x), bflo(w.y), bfhi(w.y)}; bs1 = (f32x4){bflo(w.z), bfhi(w.z), bflo(w.w), bfhi(w.w)}; }
                    const f32x4 o0 = bs0 + gv[bj][0] * acc[ai][bj][m][0], o1 = bs1 + gv[bj][1] * acc[ai][bj][m][1];
                    u32x4 w; w.x = cvt_pk_bf16(o0[0], o0[1]); w.y = cvt_pk_bf16(o0[2], o0[3]); w.z = cvt_pk_bf16(o1[0], o1[1]); w.w = cvt_pk_bf16(o1[2], o1[3]);
                    *(u32x4*)(out + off + bj * HALF) = w; } }
    }
};
template <bool F8O, bool AI = false> struct EpiSwiglu {
    static constexpr bool PERM = true; static constexpr int MID_T = 0; static constexpr bool HAS_PRE = true; static constexpr bool MAGIC = AI;
    void* Hd; int ldh, nN; float asc; const float* rs; const int* rl;
    __device__ __forceinline__ void mid(Acc&, const Unit&, int, int, int, int) const {}
    __device__ __forceinline__ void prefetch(const Unit& u, int wr, int fr, float (&p)[8]) const {
        if (rs) {
#pragma unroll
            for (int i = 0; i < 8; ++i) { const int rr_ = u.pm * BM + wr * 64 + fr + (i >> 2) * HALF + (i & 3) * 16; p[i] = rs[rl ? rl[rr_] : rr_]; } } }
    __device__ __forceinline__ void operator()(const Acc& acc, const Unit& u, int wr, int wc, int fr, int fq, const float* pre = nullptr) const {
        const int row0 = u.pm * BM + wr * 64 + fr, col0 = (u.pn - u.e * nN) * HALF + wc * 32 + 8 * fq;
#pragma unroll
        for (int ai = 0; ai < 2; ++ai)
#pragma unroll
            for (int m = 0; m < 4; ++m) { float h[8]; const int rr_ = row0 + ai * HALF + m * 16; const float sc = rs ? asc * (pre ? pre[ai * 4 + m] : rs[rl ? rl[rr_] : rr_]) : asc; const float nb = AI ? -FMAGIC * sc : 0.f, sc2 = -LOG2E * sc, nb2 = -LOG2E * nb;
#pragma unroll
                for (int n = 0; n < 2; ++n) { const f32x4 av = AI ? __builtin_elementwise_fma(acc[ai][0][m][n], (f32x4){sc, sc, sc, sc}, (f32x4){nb, nb, nb, nb}) : acc[ai][0][m][n] * sc, gv = AI ? __builtin_elementwise_fma(acc[ai][1][m][n], (f32x4){sc, sc, sc, sc}, (f32x4){nb, nb, nb, nb}) : acc[ai][1][m][n] * sc;
                    const f32x4 tv = AI ? __builtin_elementwise_fma(acc[ai][0][m][n], (f32x4){sc2, sc2, sc2, sc2}, (f32x4){nb2, nb2, nb2, nb2}) : acc[ai][0][m][n] * sc2;
                    const f32x4 dv = (f32x4){__builtin_amdgcn_exp2f(tv[0]), __builtin_amdgcn_exp2f(tv[1]), __builtin_amdgcn_exp2f(tv[2]), __builtin_amdgcn_exp2f(tv[3])} + 1.f;
                    const f32x4 hv = (av * gv) * (f32x4){__builtin_amdgcn_rcpf(dv[0]), __builtin_amdgcn_rcpf(dv[1]), __builtin_amdgcn_rcpf(dv[2]), __builtin_amdgcn_rcpf(dv[3])};
#pragma unroll
                    for (int q = 0; q < 4; ++q) h[4 * n + q] = hv[q]; }
                if constexpr (F8O) { u32x2 w; w.x = pk4_fp8(h[0], h[1], h[2], h[3]); w.y = pk4_fp8(h[4], h[5], h[6], h[7]);
                    __builtin_nontemporal_store(w, (u32x2*)((unsigned char*)Hd + (size_t)(row0 + ai * HALF + m * 16) * ldh + col0)); }
                else { u32x4 w; w.x = cvt_pk_bf16(h[0], h[1]); w.y = cvt_pk_bf16(h[2], h[3]); w.z = cvt_pk_bf16(h[4], h[5]); w.w = cvt_pk_bf16(h[6], h[7]);
                    __builtin_nontemporal_store(w, (u32x4*)((bf16*)Hd + (size_t)(row0 + ai * HALF + m * 16) * ldh + col0)); } }
    }
};
template <bool LAST> struct EpiMoeDown {
    static constexpr bool PERM = true; static constexpr int MID_T = 0; static constexpr bool HAS_PRE = false; static constexpr bool MAGIC = false;
    bf16* x; float* out; const float* gate; const int* list; const float* wl; float asc;
    __device__ __forceinline__ void mid(Acc&, const Unit&, int, int, int, int) const {}
    __device__ __forceinline__ void operator()(const Acc& acc, const Unit& u, int wr, int wc, int fr, int fq) const {
        const int col0 = (u.pn - u.e * 4) * BM + wc * 32 + 8 * fq;
#pragma unroll
        for (int ai = 0; ai < 2; ++ai) {
            int tok[4]; float wv[4]; bool val[4];
#pragma unroll
            for (int m = 0; m < 4; ++m) { const int lr = ai * HALF + wr * 64 + m * 16 + fr; val[m] = lr < u.nvalid; const int sr = u.pm * BM + (val[m] ? lr : 0); tok[m] = list[sr]; wv[m] = wl[sr] * asc; }
            u32x4 xw[4][2];
#pragma unroll
            for (int m = 0; m < 4; ++m)
#pragma unroll
                for (int bj = 0; bj < 2; ++bj) xw[m][bj] = *(const u32x4*)(x + (size_t)tok[m] * D + col0 + bj * HALF);
            asm volatile("" ::: "memory");
#pragma unroll
            for (int m = 0; m < 4; ++m) {
                if (val[m]) { const int b = tok[m] / SEQ; const float w = wv[m];
                    bf16* xr = x + (size_t)tok[m] * D + col0; float* orow = out + (size_t)tok[m] * D + col0; const float* gr = gate + (size_t)b * ADA_N + col0;
#pragma unroll
                    for (int bj = 0; bj < 2; ++bj) { const f32x4 g0 = *(const f32x4*)(gr + bj * HALF), g1 = *(const f32x4*)(gr + bj * HALF + 4); const u32x4 xv = xw[m][bj];
                        const f32x4 o0 = (f32x4){bflo(xv.x), bfhi(xv.x), bflo(xv.y), bfhi(xv.y)} + g0 * w * acc[ai][bj][m][0], o1 = (f32x4){bflo(xv.z), bfhi(xv.z), bflo(xv.w), bfhi(xv.w)} + g1 * w * acc[ai][bj][m][1];
                        if constexpr (LAST) { *(f32x4*)(orow + bj * HALF) = o0; *(f32x4*)(orow + bj * HALF + 4) = o1; }
                        else { u32x4 ow; ow.x = cvt_pk_bf16(o0[0], o0[1]); ow.y = cvt_pk_bf16(o0[2], o0[3]); ow.z = cvt_pk_bf16(o1[0], o1[1]); ow.w = cvt_pk_bf16(o1[2], o1[3]); *(u32x4*)(xr + bj * HALF) = ow; } } } } }
    }
};

template <class Epi, class Sched, class AOff, bool ALIGN_EPI, int QM = 0>
__device__ __forceinline__ void gemm_phase(LAS unsigned char* lds, const Gemm g, const Sched& S, const AOff& AO, const Epi& E) {
    constexpr bool GA = AOff::GATHER; constexpr bool F8 = QM == 1; constexpr bool MB = (QM == 2) && Epi::MAGIC;
    int tid_ = threadIdx.x; asm volatile("" : "+v"(tid_));
    const int tid = tid_, wid = __builtin_amdgcn_readfirstlane(tid >> 6), lane = tid & 63, wr = wid >> 2, wc = wid & 3, fr = lane & 15, fq = lane >> 4;
    const int K = g.K, nt = K / BK;
    unsigned voffA[2], voffB[2];
#pragma unroll
    for (int i = 0; i < 2; ++i) { int R, C; stage_rc(tid * 16 + i * 8192, R, C); const int Rb = Epi::PERM ? ((R & ~31) + perm32(R & 31)) : R; voffA[i] = (unsigned)(R * K + C) * 2u; voffB[i] = (unsigned)(Rb * K + C) * 2u; }
    const size_t kstep = (size_t)(BK * 2);
    const size_t hstep = (size_t)HALF * K * 2;
    const size_t tstep = 2 * hstep;
    const unsigned ldsw = (unsigned)wid * 1024u;
    const int aoff = lds_byte(wr * 64 + fr, fq * 8), boff = lds_byte(wc * 32 + fr, fq * 8);
#define PG8_SA(b, h) (((b) * 2 + (h)) * HTB)
#define PG8_SB(b, h) ((4 + (b) * 2 + (h)) * HTB)
#define PG8_STAGE(bufoff, gbase, voff) do { _Pragma("unroll") for (int _i = 0; _i < 2; ++_i) \
        __builtin_amdgcn_global_load_lds((const unsigned*)((const char*)(gbase) + (voff)[_i]), (LAS unsigned*)(lds + (bufoff) + ldsw + _i * 8192), 16, 0, 0); } while (0)
#define PG8_STAGE_A(bufoff, ub, h) do { if constexpr (GA) { PG8_STAGE(bufoff, ub, gOff[h]); } else { PG8_STAGE(bufoff, (ub) + (h) * hstep, voffA); } } while (0)
#define PG8_LD2(dst, addr) do { const u32x4 lo_ = *(const LAS u32x4*)(addr), hi_ = *(const LAS u32x4*)((addr) + 1024); dst = (Frag){lo_.x, lo_.y, lo_.z, lo_.w, hi_.x, hi_.y, hi_.z, hi_.w}; } while (0)
#define PG8_LDA(dst, b, h) do { _Pragma("unroll") for (int m = 0; m < 4; ++m) PG8_LD2(dst[m], lds + PG8_SA(b, h) + aoff + m * 2048); } while (0)
#define PG8_LDB(dst, b, h) do { _Pragma("unroll") for (int n = 0; n < 2; ++n) PG8_LD2(dst[n], lds + PG8_SB(b, h) + boff + n * 2048); } while (0)
#define PG8_HALF(x, k) __builtin_bit_cast(bf16x8, (u32x4){x[4 * (k)], x[4 * (k) + 1], x[4 * (k) + 2], x[4 * (k) + 3]})
#define PG8_MMA(ai, bj, At, Bt) do { __builtin_amdgcn_s_setprio(1); if constexpr (F8) { _Pragma("unroll") for (int m = 0; m < 4; ++m) _Pragma("unroll") for (int n = 0; n < 2; ++n) \
        asm volatile("v_mfma_scale_f32_16x16x128_f8f6f4 %0, %1, %2, %0, %3, %3 op_sel_hi:[0,0,0]" : "+v"(acc[ai][bj][m][n]) : "v"(Bt[n]), "v"(At[m]), "v"(sc1)); } else { \
        _Pragma("unroll") for (int m = 0; m < 4; ++m) _Pragma("unroll") for (int n = 0; n < 2; ++n) _Pragma("unroll") for (int k = 0; k < 2; ++k) \
        { if constexpr (QM == 2) acc[ai][bj][m][n] = __builtin_bit_cast(f32x4, __builtin_amdgcn_mfma_i32_16x16x64_i8(__builtin_bit_cast(v4i, PG8_HALF(Bt[n], k)), __builtin_bit_cast(v4i, PG8_HALF(At[m], k)), __builtin_bit_cast(v4i, acc[ai][bj][m][n]), 0, 0, 0)); \
          else acc[ai][bj][m][n] = __builtin_amdgcn_mfma_f32_16x16x32_bf16(PG8_HALF(Bt[n], k), PG8_HALF(At[m], k), acc[ai][bj][m][n], 0, 0, 0); } } __builtin_amdgcn_s_setprio(0); } while (0)
#define PG8_WAIT_V(n) asm volatile("s_waitcnt vmcnt(" #n ")" ::: "memory")
#define PG8_WAIT_L(n) asm volatile("s_waitcnt lgkmcnt(" #n ")" ::: "memory")
#define PG8_BAR __builtin_amdgcn_s_barrier()
#define PG8_SCHED __builtin_amdgcn_sched_barrier(0)
    Unit cur, nxt; int ui = 0;
    if (!S.next(0, cur)) return;
    unsigned gOff[2][2];
    if constexpr (GA) AO.get(cur, tid, K, gOff);
    Acc acc;
#pragma unroll
    for (int a = 0; a < 2; ++a)
#pragma unroll
        for (int b = 0; b < 2; ++b)
#pragma unroll
            for (int m = 0; m < 4; ++m)
#pragma unroll
                for (int n = 0; n < 2; ++n) { if constexpr (MB) acc[a][b][m][n] = __builtin_bit_cast(f32x4, (v4i){IMAGIC, IMAGIC, IMAGIC, IMAGIC}); else acc[a][b][m][n] = (f32x4){0.f, 0.f, 0.f, 0.f}; if constexpr (QM == 2) asm volatile("" : "+v"(acc[a][b][m][n])); }
    typedef unsigned Frag __attribute__((ext_vector_type(8)));
    Frag At[4], B0[2], B1[2];
    unsigned sc1 = 0x7F7F7F7Fu; asm volatile("" : "+v"(sc1));
    const char* cA = (const char*)g.A + (GA ? (size_t)0 : (size_t)cur.pm * tstep); const char* cB = (const char*)g.Bt + (size_t)cur.pn * tstep;
    PG8_STAGE(PG8_SB(0, 0), cB, voffB); PG8_STAGE(PG8_SB(0, 1), cB + hstep, voffB); PG8_STAGE_A(PG8_SA(0, 0), cA, 0); PG8_STAGE_A(PG8_SA(0, 1), cA, 1);
    if (wr == 1) PG8_BAR;
    PG8_WAIT_V(2); PG8_BAR;
    PG8_STAGE(PG8_SB(1, 0), cB + kstep, voffB); PG8_STAGE_A(PG8_SA(1, 0), cA + kstep, 0); PG8_STAGE(PG8_SB(1, 1), cB + hstep + kstep, voffB);
    PG8_WAIT_V(6); PG8_BAR;
    for (;;) {
        const bool has_next = S.next(ui + 1, nxt);
        float pre[8];
        int nrow[2][2]; if constexpr (GA) { if (has_next) AO.rows(nxt, tid, nrow); }
        const char* nA = (GA || !has_next) ? cA : (const char*)g.A + (size_t)nxt.pm * tstep; const char* nB = has_next ? (const char*)g.Bt + (size_t)nxt.pn * tstep : cB;
#pragma nounroll
        for (int t = 0; t < nt; t += 2) {
            if (Epi::MID_T != 0 && t == Epi::MID_T) E.mid(acc, cur, wr, wc, fr, fq);
            const bool last = (t == nt - 2);
            const char* a1 = cA + (size_t)(t + 1) * kstep;
            PG8_LDB(B0, 0, 0); PG8_LDB(B1, 0, 1); PG8_SCHED; PG8_LDA(At, 0, 0); PG8_STAGE_A(PG8_SA(1, 1), a1, 1);
            if (last) { cA = nA; if constexpr (GA) { if (has_next) AO.offs(nrow, tid, K, gOff); } }
            if constexpr (Epi::HAS_PRE) { if (last) E.prefetch(cur, wr, fr, pre); }
            const char* a2 = last ? cA : cA + (size_t)(t + 2) * kstep; const char* b2 = last ? nB : cB + (size_t)(t + 2) * kstep;
            const char* a3 = a2 + kstep; const char* b3 = b2 + kstep;
            PG8_WAIT_V(8); PG8_WAIT_L(0); PG8_BAR; PG8_MMA(0, 0, At, B0); PG8_MMA(0, 1, At, B1); PG8_BAR; PG8_SCHED;
            PG8_LDA(At, 0, 1); PG8_STAGE(PG8_SB(0, 0), b2, voffB); PG8_STAGE(PG8_SB(0, 1), b2 + hstep, voffB); PG8_STAGE_A(PG8_SA(0, 0), a2, 0);
            PG8_WAIT_V(8); PG8_WAIT_L(0); PG8_BAR; PG8_MMA(1, 0, At, B0); PG8_MMA(1, 1, At, B1); PG8_BAR; PG8_SCHED;
            PG8_LDB(B0, 1, 0); PG8_LDB(B1, 1, 1); PG8_SCHED; PG8_LDA(At, 1, 0); PG8_STAGE_A(PG8_SA(0, 1), a2, 1);
            PG8_WAIT_V(8); PG8_WAIT_L(0); PG8_BAR; PG8_MMA(0, 0, At, B0); PG8_MMA(0, 1, At, B1); PG8_BAR; PG8_SCHED;
            PG8_LDA(At, 1, 1); PG8_STAGE(PG8_SB(1, 0), b3, voffB); PG8_STAGE(PG8_SB(1, 1), b3 + hstep, voffB); PG8_STAGE_A(PG8_SA(1, 0), a3, 0);
            PG8_WAIT_V(8); PG8_WAIT_L(0); PG8_BAR; PG8_MMA(1, 0, At, B0); PG8_MMA(1, 1, At, B1); PG8_BAR; PG8_SCHED;
        }
        if constexpr (F8) asm volatile("s_nop 15\n\ts_nop 15" ::: "memory");
        if constexpr (ALIGN_EPI) { if (wr == 0) PG8_BAR; }
        if constexpr (QM == 2 && !MB) {
#pragma unroll
            for (int a = 0; a < 2; ++a)
#pragma unroll
                for (int b = 0; b < 2; ++b)
#pragma unroll
                    for (int m = 0; m < 4; ++m)
#pragma unroll
                        for (int n = 0; n < 2; ++n) acc[a][b][m][n] = acc_i2f(acc[a][b][m][n]); }
        { int te_ = threadIdx.x; asm volatile("" : "+v"(te_));
          const int le_ = te_ & 63; if constexpr (Epi::HAS_PRE) E(acc, cur, wr, wc, le_ & 15, le_ >> 4, pre); else E(acc, cur, wr, wc, le_ & 15, le_ >> 4); }
        if (!has_next) break;
#pragma unroll
        for (int a = 0; a < 2; ++a)
#pragma unroll
            for (int b = 0; b < 2; ++b)
#pragma unroll
                for (int m = 0; m < 4; ++m)
#pragma unroll
                    for (int n = 0; n < 2; ++n) { if constexpr (MB) acc[a][b][m][n] = __builtin_bit_cast(f32x4, (v4i){IMAGIC, IMAGIC, IMAGIC, IMAGIC}); else acc[a][b][m][n] = (f32x4){0.f, 0.f, 0.f, 0.f}; if constexpr (QM == 2) asm volatile("" : "+v"(acc[a][b][m][n])); }
        cur = nxt; cB = nB; ++ui;
        if constexpr (ALIGN_EPI) { if (wr == 1) PG8_BAR; }
    }
    PG8_WAIT_V(0);
    if constexpr (!ALIGN_EPI) { if (wr == 0) PG8_BAR; }
    PG8_BAR;
#undef PG8_SA
#undef PG8_SB
#undef PG8_STAGE
#undef PG8_STAGE_A
#undef PG8_LDA
#undef PG8_LDB
#undef PG8_MMA
#undef PG8_HALF
#undef PG8_LD2
#undef PG8_WAIT_V
#undef PG8_WAIT_L
#undef PG8_BAR
#undef PG8_SCHED
}
}

#define XB_TMO      128
#define XB_XCNT(j)  (256  + 64 * (j))
#define XB_XSUB(j)  (1280 + 64 * (j))
#define XB_XGEN(j)  (2304 + 64 * (j))
#define XB_TOP      3328
#define XB_TOPGEN   3392
#define XCD_BAR_WORDS 3456
#define XB_SPIN_CAP (1u << 23)
__device__ __forceinline__ unsigned xb_ld(unsigned* p)              { return __hip_atomic_load(p, __ATOMIC_RELAXED, __HIP_MEMORY_SCOPE_AGENT); }
__device__ __forceinline__ unsigned xb_add(unsigned* p, unsigned v) { return __hip_atomic_fetch_add(p, v, __ATOMIC_RELAXED, __HIP_MEMORY_SCOPE_AGENT); }
__device__ __forceinline__ unsigned xb_xcc_id() { return (unsigned)__builtin_amdgcn_s_getreg((3 << 11) | 20) & 0xFu; }
#define XB_SPIN(cond, bar) do { unsigned _sp = 0; while (cond) { __builtin_amdgcn_s_sleep(1); \
    if ((++_sp & 255u) == 0u) { if (xb_ld(&(bar)[XB_TMO])) break; if (_sp > XB_SPIN_CAP) { atomicAdd(&(bar)[XB_TMO], 1u); break; } } } } while (0)
struct XcdBarrier { unsigned* bar; unsigned x; volatile LAS unsigned* st; };
__device__ __forceinline__ XcdBarrier xcd_barrier_post(unsigned* bar, volatile LAS unsigned* st) {
    XcdBarrier b; b.bar = bar; b.x = xb_xcc_id(); b.st = st;
    if (threadIdx.x == 0) (void)xb_add(&bar[XB_XCNT(b.x)], 1u);
    return b;
}
__device__ __forceinline__ void xcd_barrier_complete(unsigned* bar, unsigned x, unsigned& nloc, unsigned& nx) {
    const unsigned G = gridDim.x * gridDim.y * gridDim.z;
    unsigned sum, cnt, mine, sp = 0u;
    for (;;) {
        sum = 0u; cnt = 0u; mine = 0u;
#pragma unroll
        for (unsigned j = 0; j < 16; ++j) { const unsigned c = xb_ld(&bar[XB_XCNT(j)]); sum += c; cnt += (c > 0u) ? 1u : 0u; mine = (j == x) ? c : mine; }
        if (sum == G) break;
        __builtin_amdgcn_s_sleep(1);
        if ((++sp & 255u) == 0u) { if (xb_ld(&bar[XB_TMO])) break; if (sp > XB_SPIN_CAP) { atomicAdd(&bar[XB_TMO], 1u); break; } }
    }
    nloc = mine > 0u ? mine : 1u; nx = cnt > 0u ? cnt : 1u;
}
__device__ __forceinline__ void xcd_barrier(const XcdBarrier& b) {
    asm volatile("s_waitcnt vmcnt(0)" ::: "memory");
    __syncthreads();
    if (threadIdx.x == 0) {
        unsigned* bar = b.bar; unsigned bx_ = __builtin_amdgcn_readfirstlane(b.x);
        asm volatile("" : "+s"(bar), "+s"(bx_));
        __builtin_amdgcn_s_waitcnt(0);
        unsigned nloc = b.st[0], nx = b.st[1];
        if (nloc == 0u) { xcd_barrier_complete(bar, bx_, nloc, nx); b.st[0] = nloc; b.st[1] = nx; }
        const unsigned old = xb_add(&bar[XB_XSUB(bx_)], 1u);
        const unsigned gen = old / nloc;
        if (old + 1u == (gen + 1u) * nloc) {
            __builtin_amdgcn_fence(__ATOMIC_RELEASE, "agent");
            asm volatile("s_waitcnt vmcnt(0)" ::: "memory");
            const unsigned og = xb_add(&bar[XB_TOP], 1u);
            const unsigned tg = og / nx;
            if (og + 1u == (tg + 1u) * nx) xb_add(&bar[XB_TOPGEN], 1u);
            else XB_SPIN(xb_ld(&bar[XB_TOPGEN]) == tg, bar);
            __builtin_amdgcn_fence(__ATOMIC_ACQUIRE, "agent");
            xb_add(&bar[XB_XGEN(bx_)], 1u);
            asm volatile("s_waitcnt vmcnt(0)" ::: "memory");
        } else {
            XB_SPIN(xb_ld(&bar[XB_XGEN(bx_)]) == gen, bar);
            __builtin_amdgcn_fence(__ATOMIC_ACQUIRE, "agent");
            asm volatile("s_waitcnt vmcnt(0)" ::: "memory");
        }
    }
    __syncthreads();
}

struct Frame {
    LAS unsigned char* lds;
    volatile LAS unsigned* LC;
    gu32* ctl;
    int tid, lane, wave, vcu, G, bx;
    unsigned char* ws;
    float* adaf;
};

__device__ __forceinline__ void transpose_item(const float* W, int N, bf16* WT, int ldk, int koff, int mode, LAS float* scr, int item, int lane) {
    const int nblk = N / 32, kb = item / nblk, nb = item % nblk, k0 = 64 * kb, n0 = 32 * nb;
    float v_[32];
#pragma unroll
    for (int i = 0; i < 32; ++i) { const int kk = 2 * i + (lane >> 5); v_[i] = W[(size_t)(k0 + kk) * N + n0 + (lane & 31)]; }
#pragma unroll
    for (int i = 0; i < 32; ++i) { const int kk = 2 * i + (lane >> 5); scr[kk * 33 + (lane & 31)] = v_[i]; }
    LDS_WAIT(); asm volatile("" ::: "memory");
    const int c = lane & 7;
    const int d0 = mode == 0 ? n0 : ((n0 >> 7) * 256 + (mode == 2 ? 128 : 0) + (n0 & 127));
#pragma unroll
    for (int j = 0; j < 4; ++j) { const int n = (lane >> 3) + 8 * j; const LAS float* s = scr + (8 * c) * 33 + n;
        u32x4 o; o.x = pk2(s[0 * 33], s[1 * 33]); o.y = pk2(s[2 * 33], s[3 * 33]); o.z = pk2(s[4 * 33], s[5 * 33]); o.w = pk2(s[6 * 33], s[7 * 33]);
        *(u32x4*)(WT + (size_t)(d0 + n) * ldk + koff + k0 + 8 * c) = o; }
    LDS_WAIT(); asm volatile("" ::: "memory");
}

#define PHASE_ENTER(F) do { int t_ = threadIdx.x; asm volatile("" : "+v"(t_)); (F).tid = t_; (F).lane = t_ & 63; (F).wave = __builtin_amdgcn_readfirstlane(t_ >> 6); \
    int b_ = blockIdx.x; asm volatile("" : "+s"(b_)); (F).bx = b_; (F).vcu = ((F).G % 8 == 0) ? (b_ % 8) * ((F).G / 8) + b_ / 8 : b_; } while (0)
__device__ __forceinline__ void transpose_item_f8(const float* W, int N, unsigned char* WT, int ldk, int koff, int mode, LAS float* scr, int item, int lane, int nblk_ = 0) {
    const int nblk = nblk_ ? nblk_ : N / 32, kb = item / nblk, nb = item % nblk, k0 = 64 * kb, n0 = 32 * nb;
    float v_[32];
#pragma unroll
    for (int i = 0; i < 32; ++i) { const int kk = 2 * i + (lane >> 5); v_[i] = W[(size_t)(k0 + kk) * N + n0 + (lane & 31)]; }
#pragma unroll
    for (int i = 0; i < 32; ++i) { const int kk = 2 * i + (lane >> 5); scr[kk * 33 + (lane & 31)] = v_[i] * W8_SCALE; }
    LDS_WAIT(); asm volatile("" ::: "memory");
    const int c = lane & 7;
    const int d0 = mode == 0 ? n0 : ((n0 >> 7) * 256 + (mode == 2 ? 128 : 0) + (n0 & 127));
#pragma unroll
    for (int j = 0; j < 4; ++j) { const int n = (lane >> 3) + 8 * j; const LAS float* sp = scr + (8 * c) * 33 + n;
        u32x2 o; o.x = pk4_fp8(sp[0 * 33], sp[1 * 33], sp[2 * 33], sp[3 * 33]); o.y = pk4_fp8(sp[4 * 33], sp[5 * 33], sp[6 * 33], sp[7 * 33]);
        *(u32x2*)(WT + (size_t)(d0 + n) * ldk + koff + k0 + 8 * c) = o; }
    LDS_WAIT(); asm volatile("" ::: "memory");
}
__device__ __forceinline__ void transpose_item_i8(const float* W, int N, unsigned char* WT, int ldk, int koff, int mode, LAS float* scr, int item, int lane, int nblk_ = 0) {
    const int nblk = nblk_ ? nblk_ : N / 32, kb = item / nblk, nb = item % nblk, k0 = 64 * kb, n0 = 32 * nb;
    float v_[32];
#pragma unroll
    for (int i = 0; i < 32; ++i) { const int kk = 2 * i + (lane >> 5); v_[i] = W[(size_t)(k0 + kk) * N + n0 + (lane & 31)]; }
#pragma unroll
    for (int i = 0; i < 32; ++i) { const int kk = 2 * i + (lane >> 5); scr[kk * 33 + (lane & 31)] = v_[i] * QW_SCALE; }
    LDS_WAIT(); asm volatile("" ::: "memory");
    const int c = lane & 7;
    const int d0 = mode == 0 ? n0 : ((n0 >> 7) * 256 + (mode == 2 ? 128 : 0) + (n0 & 127));
#pragma unroll
    for (int j = 0; j < 4; ++j) { const int n = (lane >> 3) + 8 * j; const LAS float* sp = scr + (8 * c) * 33 + n;
        u32x2 o; o.x = pk4_i8(sp[0 * 33], sp[1 * 33], sp[2 * 33], sp[3 * 33]); o.y = pk4_i8(sp[4 * 33], sp[5 * 33], sp[6 * 33], sp[7 * 33]);
        *(u32x2*)(WT + (size_t)(d0 + n) * ldk + koff + k0 + 8 * c) = o; }
    LDS_WAIT(); asm volatile("" ::: "memory");
}
struct Args { const float* in[23]; float* out; unsigned char* ws; int pad0, pad1; };

struct TItem { const float* W; unsigned char* WT; int N, ldk, mode, k0, n0, f8, koff; };
__device__ __forceinline__ void titem_load(const TItem& t, int lane, float (&v)[32]) {
#pragma unroll
    for (int i = 0; i < 32; ++i) { const int kk = 2 * i + (lane >> 5); v[i] = t.W[(size_t)(t.k0 + kk) * t.N + t.n0 + (lane & 31)]; } }
__device__ __forceinline__ void titem_finish(const TItem& t, int lane, const float (&v)[32], LAS float* scr) {
    const float sc = t.f8 == 2 ? 1.f : (t.f8 ? W8_SCALE : QW_SCALE);
#pragma unroll
    for (int i = 0; i < 32; ++i) { const int kk = 2 * i + (lane >> 5); scr[kk * 33 + (lane & 31)] = v[i] * sc; }
    LDS_WAIT(); asm volatile("" ::: "memory");
    const int c = lane & 7;
    const int d0 = t.mode == 0 ? t.n0 : ((t.n0 >> 7) * 256 + (t.mode == 2 ? 128 : 0) + (t.n0 & 127));
#pragma unroll
    for (int j = 0; j < 4; ++j) { const int n = (lane >> 3) + 8 * j; const LAS float* sp = scr + (8 * c) * 33 + n;
        if (t.f8 == 2) { u32x4 o; o.x = pk2(sp[0 * 33], sp[1 * 33]); o.y = pk2(sp[2 * 33], sp[3 * 33]); o.z = pk2(sp[4 * 33], sp[5 * 33]); o.w = pk2(sp[6 * 33], sp[7 * 33]);
            *(u32x4*)((bf16*)t.WT + (size_t)(d0 + n) * t.ldk + t.koff + t.k0 + 8 * c) = o; }
        else { u32x2 o;
            if (t.f8) { o.x = pk4_fp8(sp[0 * 33], sp[1 * 33], sp[2 * 33], sp[3 * 33]); o.y = pk4_fp8(sp[4 * 33], sp[5 * 33], sp[6 * 33], sp[7 * 33]); }
            else { o.x = pk4_i8(sp[0 * 33], sp[1 * 33], sp[2 * 33], sp[3 * 33]); o.y = pk4_i8(sp[4 * 33], sp[5 * 33], sp[6 * 33], sp[7 * 33]); }
            *(u32x2*)(t.WT + (size_t)(d0 + n) * t.ldk + t.koff + t.k0 + 8 * c) = o; } }
    LDS_WAIT(); asm volatile("" ::: "memory");
}
__device__ __forceinline__ void phase_prologue(Frame& F, const Args& a, int part) {
    PHASE_ENTER(F);
    if (part == 0) {
    {
        LAS float* cs = (LAS float*)F.lds;
        LAS float* red = (LAS float*)(F.lds + 32768);
        if (F.bx < 2 * (ADA_N / 64)) {
            for (int i = F.tid; i < NB * D; i += NTHR) { const float c = a.in[1][i]; cs[i] = c * sigm(c); }
            __syncthreads();
            for (int it = F.bx; it < 2 * (ADA_N / 64); it += F.G) {
                const int l = it / (ADA_N / 64), j = (it % (ADA_N / 64)) * 64 + F.lane;
                const float* w = a.in[2] + (size_t)l * D * ADA_N + j;
                float acc[NB];
#pragma unroll
                for (int b = 0; b < NB; ++b) acc[b] = 0.f;
                for (int i = F.wave * 128; i < F.wave * 128 + 128; ++i) { const float wv = w[(size_t)i * ADA_N];
#pragma unroll
                    for (int b = 0; b < NB; ++b) acc[b] += cs[b * D + i] * wv; }
#pragma unroll
                for (int b = 0; b < NB; ++b) red[(F.wave * NB + b) * 64 + F.lane] = acc[b];
                __syncthreads();
                { const int b = F.tid >> 6, jj = F.tid & 63; float s = 0.f;
#pragma unroll
                  for (int w8 = 0; w8 < 8; ++w8) s += red[(w8 * NB + b) * 64 + jj];
                  const int col = (it % (ADA_N / 64)) * 64 + jj;
                  F.adaf[AO_ADA + ((size_t)l * NB + b) * ADA_N + col] = s + a.in[3][(size_t)l * ADA_N + col]; }
                __syncthreads();
            }
        }
        __syncthreads();
    }
    if (F.bx == F.G - 1) {
        { const int i = F.tid;
          const float l0 = a.in[7][i], l1 = a.in[7][512 + i];
          F.adaf[AO_LB + i] = 0.f; F.adaf[AO_LB + 512 + i] = 1.f / (1.f + __expf(l0 - l1)); }
        if (F.wave < 2) { const int l = F.wave; const float* lv = a.in[11] + l * 256;
            const float s1 = wave_sum(lv[F.lane] * lv[64 + F.lane]), s2 = wave_sum(lv[128 + F.lane] * lv[192 + F.lane]);
            const float li = 0.8f - 0.6f * __expf(-0.3f * (float)l);
            float mq = fabsf(a.in[9][l * 64 + F.lane]), mk = fabsf(a.in[10][l * 64 + F.lane]);
#pragma unroll
            for (int o = 1; o < 64; o <<= 1) { mq = fmaxf(mq, __shfl_xor(mq, o)); mk = fmaxf(mk, __shfl_xor(mk, o)); }
            const float B2 = 8.f * LOG2E * mq * mk * 1.05f;
            if (F.lane == 0) { F.adaf[AO_MISC + l * 8 + 0] = __expf(s1) - __expf(s2) + li; F.adaf[AO_MISC + l * 8 + 1] = li; F.adaf[AO_MISC + l * 8 + 2] = B2; }
            int cst[2], key[2];
#pragma unroll
            for (int e = 0; e < 2; ++e) { const int j = F.lane + 64 * e, h = j >> 5, qb = j & 31;
                const float win = (150.f + 2.f * B2) / (exp2f(-2.f * (float)(h + 1)) * LOG2E); const int wi = win < 8192.f ? (int)win + 1 : 8192;
                int ts = (128 * qb - wi) >> 6; if (ts < 0) ts = 0;
                cst[e] = 2 * qb + 2 - ts; key[e] = j; if (qb == 0 && F.lane < 64) F.adaf[AO_MISC + l * 8 + 3 + h] = (float)wi; }
            int rk[2] = {0, 0};
            for (int j2 = 0; j2 < 128; ++j2) { const int c2 = __shfl(cst[j2 >> 6], j2 & 63);
#pragma unroll
                for (int e = 0; e < 2; ++e) rk[e] += (c2 > cst[e] || (c2 == cst[e] && j2 < key[e])) ? 1 : 0; }
            int* ord = (int*)(F.adaf + AO_ORD) + l * 1024;
#pragma unroll
            for (int e = 0; e < 2; ++e) { const int h = key[e] >> 5, qb = key[e] & 31;
#pragma unroll
                for (int b = 0; b < NB; ++b) ord[rk[e] * 8 + b] = ((b * 4 + h) << 5) | qb; } }
    }
    }
    LAS float* scr = (LAS float*)(F.lds + F.wave * 16384);
    const int gw = F.vcu * NWAVES + F.wave, NGW = F.G * NWAVES;
    constexpr int I_IN = 16 * (DIN / 32), I_P = 8 * 32, I_O = 16 * 32, I_13 = 16 * (DFF / 32), I_2 = (DFF / 64) * 32;
    constexpr int I_G8a = 16 * (1024 / 32), I_G8 = 16 * (2560 / 32);
    constexpr int NIT = 2 * (I_IN + 2 * I_P + I_O) + 2 * I_13 + I_2;
    constexpr int NIT0 = I_IN + 2 * I_P + I_O;
    auto decode = [&](int it) { TItem t; int r = it; t.koff = 0; t.mode = 0; t.ldk = D; t.f8 = 2; t.N = D; t.W = a.in[18]; t.WT = a.ws + WS_W2; bool done = false;
#pragma unroll
        for (int l = 0; l < 2; ++l) { if (done) break;
            if (r < I_IN) { t.W = a.in[6] + (size_t)l * D * DIN; t.N = DIN; t.WT = a.ws + WS_WIN8 + (size_t)l * DIN * D; t.f8 = 0; done = true; break; } r -= I_IN;
            if (r < I_P) { t.W = a.in[13] + (size_t)l * 512 * D; t.WT = a.ws + WS_WPAB + (size_t)l * D * D * 2; done = true; break; } r -= I_P;
            if (r < I_P) { t.W = a.in[14] + (size_t)l * 512 * D; t.WT = a.ws + WS_WPAB + (size_t)l * D * D * 2; t.koff = 512; done = true; break; } r -= I_P;
            if (r < I_O) { t.W = a.in[15] + (size_t)l * D * D; t.WT = a.ws + WS_WO + (size_t)l * D * D * 2; done = true; break; } r -= I_O; }
        if (!done) {
            if (r < I_13) { t.W = a.in[16]; t.N = DFF; t.WT = a.ws + WS_W13; t.f8 = 0; t.mode = 1; }
            else if (r < 2 * I_13) { r -= I_13; t.W = a.in[17]; t.N = DFF; t.WT = a.ws + WS_W13; t.f8 = 0; t.mode = 2; }
            else { r -= 2 * I_13; t.ldk = DFF; } }
        const int nblk = t.N / 32; t.k0 = 64 * (r / nblk); t.n0 = 32 * (r % nblk); return t; };
    const int IT0 = (part == 0 ? 0 : NIT0) + gw, IT1 = part == 0 ? NIT0 : NIT;
    if (IT0 >= IT1) return;
    float va[32], vb[32];
    TItem ta = decode(IT0), tb = ta; titem_load(ta, F.lane, va);
    for (int it = IT0; it < IT1; it += 2 * NGW) {
        const bool hb = it + NGW < IT1; if (hb) { tb = decode(it + NGW); titem_load(tb, F.lane, vb); }
        titem_finish(ta, F.lane, va, scr);
        const bool ha = it + 2 * NGW < IT1; if (ha) { ta = decode(it + 2 * NGW); titem_load(ta, F.lane, va); }
        if (hb) titem_finish(tb, F.lane, vb, scr);
    }
}
__device__ __forceinline__ void phase_moe_weights(Frame& F, const Args& a) {
    PHASE_ENTER(F);
    LAS float* scr = (LAS float*)(F.lds + F.wave * 16384);
    const int gw = F.vcu * NWAVES + F.wave, NGW = F.G * NWAVES;
    constexpr int I_1 = 16 * (DFFE / 32), I_2 = (DFFE / 64) * 32, PER_E = 2 * I_1 + I_2, TOTAL = NEXP * PER_E;
    auto decode = [&](int it) { TItem t; const int e = it / PER_E; int r = it % PER_E;
        if (r < 2 * I_1) { const int w3 = r >= I_1; if (w3) r -= I_1; const int nblk = DFFE / 32; t.W = a.in[w3 ? 21 : 20] + (size_t)e * D * DFFE; t.N = DFFE; t.WT = a.ws + WS_MW13 + (size_t)e * 2 * DFFE * D; t.ldk = D; t.mode = w3 ? 2 : 1; t.k0 = 64 * (r / nblk); t.n0 = 32 * (r % nblk); t.f8 = 0; t.koff = 0; }
        else { r -= 2 * I_1; const int nblk = D / 32; t.W = a.in[22] + (size_t)e * DFFE * D; t.N = D; t.WT = a.ws + WS_MW2 + (size_t)e * D * DFFE; t.ldk = DFFE; t.mode = 0; t.k0 = 64 * (r / nblk); t.n0 = 32 * (r % nblk); t.f8 = 1; t.koff = 0; }
        return t; };
    float va[32], vb[32], vc[32];
    if (gw >= TOTAL) return;
    TItem ta = decode(gw), tb = ta, tc = ta; titem_load(ta, F.lane, va);
    bool hb = gw + NGW < TOTAL; if (hb) { tb = decode(gw + NGW); titem_load(tb, F.lane, vb); }
    for (int it = gw; it < TOTAL; it += 3 * NGW) {
        const bool hc = it + 2 * NGW < TOTAL; if (hc) { tc = decode(it + 2 * NGW); titem_load(tc, F.lane, vc); }
        titem_finish(ta, F.lane, va, scr);
        const bool ha = it + 3 * NGW < TOTAL; if (ha) { ta = decode(it + 3 * NGW); titem_load(ta, F.lane, va); }
        if (hb) titem_finish(tb, F.lane, vb, scr);
        hb = it + 4 * NGW < TOTAL; if (hb) { tb = decode(it + 4 * NGW); titem_load(tb, F.lane, vb); }
        if (hc) titem_finish(tc, F.lane, vc, scr);
    }
}

template <bool MOE, int F8O, bool XB16>
__device__ __forceinline__ void phase_norm(Frame& F, const void* x, const float* gain, const float* ada_l, int sh_chunk, int sc_chunk, void* H, void* H2, float* rsv, const float* router, int* toke, float* tokw) {
    PHASE_ENTER(F);
    f32x2 rw[MOE ? 16 : 1][MOE ? 4 : 1];
    if constexpr (MOE) {
        for (int i = F.tid; i < 16; i += NTHR) F.LC[LC_LH + i] = 0u;
        __syncthreads();
#pragma unroll
        for (int j = 0; j < 4; ++j)
#pragma unroll
            for (int c = 0; c < 4; ++c) { const float* rp = router + (size_t)(256 * j + 4 * F.lane + c) * NEXP; const f32x4 r0 = *(const f32x4*)rp, r1 = *(const f32x4*)(rp + 4);
                rw[4 * j + c][0] = (f32x2){r0[0], r0[1]}; rw[4 * j + c][1] = (f32x2){r0[2], r0[3]}; rw[4 * j + c][2] = (f32x2){r1[0], r1[1]}; rw[4 * j + c][3] = (f32x2){r1[2], r1[3]}; }
    }
    const int rows_per = (M + F.G - 1) / F.G, r0 = F.bx * rows_per, r1 = (r0 + rows_per < M) ? r0 + rows_per : M;
    f32x4 nfA[4], nfB[4]; u32x2 nhA[4], nhB[4];
#define NORM_LOAD(nf_, nh_, mm) do { if ((mm) < r1) { _Pragma("unroll") for (int j = 0; j < 4; ++j) { if constexpr (XB16) nh_[j] = ((const u32x2*)((const bf16*)x + (size_t)(mm) * D) + F.lane)[64 * j]; else nf_[j] = ((const f32x4*)((const float*)x + (size_t)(mm) * D) + F.lane)[64 * j]; } } } while (0)
    int bcur = -1; f32x4 gA[4], gS[4];
#pragma unroll
    for (int j = 0; j < 4; ++j) { gA[j] = (f32x4){0.f, 0.f, 0.f, 0.f}; gS[j] = gA[j]; nfA[j] = gA[j]; nfB[j] = gA[j]; nhA[j] = (u32x2){0u, 0u}; nhB[j] = nhA[j]; }
    auto row = [&](const f32x4 (&nf_)[4], const u32x2 (&nh_)[4], const int m) __attribute__((always_inline)) {
        const int b = m / SEQ;
        f32x4 v[4]; float s = 0.f;
#pragma unroll
        for (int j = 0; j < 4; ++j) { if constexpr (XB16) v[j] = (f32x4){bflo(nh_[j].x), bfhi(nh_[j].x), bflo(nh_[j].y), bfhi(nh_[j].y)}; else v[j] = nf_[j]; }
#pragma unroll
        for (int j = 0; j < 4; ++j) { s += (v[j].x * v[j].x + v[j].y * v[j].y) + (v[j].z * v[j].z + v[j].w * v[j].w); }
        const float rstd = __builtin_amdgcn_rsqf(wave_sum(s) * (1.f / D) + EPS);
        if (b != bcur) {
            const float* ab = ada_l + (size_t)b * ADA_N; bcur = b;
#pragma unroll
            for (int j = 0; j < 4; ++j) { const int col = 256 * j + 4 * F.lane; gA[j] = *(const f32x4*)(gain + col) * (*(const f32x4*)(ab + sc_chunk * D + col) + 1.f); gS[j] = *(const f32x4*)(ab + sh_chunk * D + col); } }
        f32x4 yv[4]; float amax = 0.f;
        u32x2* o8 = (u32x2*)((bf16*)H + (size_t)m * D) + F.lane; unsigned* o4 = (unsigned*)((unsigned char*)(F8O == 2 ? H2 : H) + (size_t)m * D) + F.lane;
        float lg[8]; f32x2 lg2[4];
#pragma unroll
        for (int e = 0; e < 8; ++e) lg[e] = 0.f;
#pragma unroll
        for (int e = 0; e < 4; ++e) lg2[e] = (f32x2){0.f, 0.f};
#pragma unroll
        for (int j = 0; j < 4; ++j) { const int col = 256 * j + 4 * F.lane;
            const f32x4 y = (v[j] * rstd) * gA[j] + gS[j]; yv[j] = y; amax = fmaxf(fmaxf(amax, fmaxf(fabsf(y.x), fabsf(y.y))), fmaxf(fabsf(y.z), fabsf(y.w)));
            if constexpr (F8O != 1) { u32x2 w; w.x = pk2(y.x, y.y); w.y = pk2(y.z, y.w); o8[64 * j] = w; }
            if constexpr (MOE) {
#pragma unroll
                for (int c = 0; c < 4; ++c)
#pragma unroll
                    for (int e = 0; e < 4; ++e) lg2[e] = __builtin_elementwise_fma((f32x2){y[c], y[c]}, rw[4 * j + c][e], lg2[e]); } }
        if constexpr (F8O != 0) {
            amax = wave_max(amax);
            amax = fmaxf(amax, 1e-20f); const float qs = 127.f * __builtin_amdgcn_rcpf(amax);
#pragma unroll
            for (int j = 0; j < 4; ++j) o4[64 * j] = pk4_i8(yv[j].x * qs, yv[j].y * qs, yv[j].z * qs, yv[j].w * qs);
            if (F.lane == 0) rsv[m] = amax * (1.f / 127.f);
        }
        if constexpr (MOE) {
#pragma unroll
            for (int e = 0; e < 4; ++e) { lg[2 * e] = lg2[e].x; lg[2 * e + 1] = lg2[e].y; }
            {
                const bool h32 = F.lane & 32, h16 = F.lane & 16, h8 = F.lane & 8; float s4[4], k4[4], a4[4], s2[2], k2[2], b2[2];
#pragma unroll
                for (int k = 0; k < 4; ++k) { s4[k] = h32 ? lg[k] : lg[4 + k]; k4[k] = h32 ? lg[4 + k] : lg[k]; }
#pragma unroll
                for (int k = 0; k < 4; ++k) s4[k] = __shfl_xor(s4[k], 32);
#pragma unroll
                for (int k = 0; k < 4; ++k) a4[k] = k4[k] + s4[k];
#pragma unroll
                for (int k = 0; k < 2; ++k) { s2[k] = h16 ? a4[k] : a4[2 + k]; k2[k] = h16 ? a4[2 + k] : a4[k]; }
#pragma unroll
                for (int k = 0; k < 2; ++k) s2[k] = __builtin_bit_cast(float, __builtin_amdgcn_ds_swizzle(__builtin_bit_cast(int, s2[k]), 0x401f));
#pragma unroll
                for (int k = 0; k < 2; ++k) b2[k] = k2[k] + s2[k];
                const float snd = h8 ? b2[0] : b2[1]; float c1 = (h8 ? b2[1] : b2[0]) + __builtin_bit_cast(float, __builtin_amdgcn_mov_dpp(__builtin_bit_cast(int, snd), 0x128, 0xf, 0xf, true));
                c1 += __builtin_bit_cast(float, __builtin_amdgcn_mov_dpp(__builtin_bit_cast(int, c1), 0x141, 0xf, 0xf, true));
                c1 += __builtin_bit_cast(float, __builtin_amdgcn_mov_dpp(__builtin_bit_cast(int, c1), 0xB1, 0xf, 0xf, true));
                c1 += __builtin_bit_cast(float, __builtin_amdgcn_mov_dpp(__builtin_bit_cast(int, c1), 0x4E, 0xf, 0xf, true));
#pragma unroll
                for (int e = 0; e < 8; ++e) lg[e] = __builtin_bit_cast(float, __builtin_amdgcn_readlane(__builtin_bit_cast(int, c1), 8 * e)); }
            int e0 = 0; float v0 = lg[0];
#pragma unroll
            for (int e = 1; e < 8; ++e) if (lg[e] > v0) { v0 = lg[e]; e0 = e; }
            int e1 = -1; float v1 = 0.f;
#pragma unroll
            for (int e = 0; e < 8; ++e) if (e != e0 && (e1 < 0 || lg[e] > v1)) { v1 = lg[e]; e1 = e; }
            if (F.lane == 0) { const float w0 = __builtin_amdgcn_rcpf(1.f + __expf(v1 - v0));
                toke[2 * m] = e0; toke[2 * m + 1] = e1; tokw[2 * m] = w0; tokw[2 * m + 1] = 1.f - w0;
                lds_inc(&F.LC[LC_LH + e0]); lds_inc(&F.LC[LC_LH + 8 + e1]); }
        }
    };
    NORM_LOAD(nfA, nhA, r0 + F.wave);
    for (int m = r0 + F.wave; m < r1; m += 2 * NWAVES) {
        NORM_LOAD(nfB, nhB, m + NWAVES);
        row(nfA, nhA, m);
        NORM_LOAD(nfA, nhA, m + 2 * NWAVES);
        if (m + NWAVES < r1) row(nfB, nhB, m + NWAVES);
    }
    if constexpr (MOE) {
        __syncthreads();
        if (F.tid < 16) __hip_atomic_fetch_add(F.ctl + CW_MOE + F.tid * 64, F.LC[LC_LH + F.tid], RLX_AGENT);
    }
#undef NORM_LOAD
}
__device__ __forceinline__ void phase_moe_sort(Frame& F, const int* toke, const float* tokw, int* list, float* wl, const float* rs, float* rsl) {
    PHASE_ENTER(F);
    if (F.tid < 16) F.LC[LC_CNT + F.tid] = __hip_atomic_load(F.ctl + CW_MOE + F.tid * 64, RLX_AGENT);
    if (F.tid >= 64 && F.tid < 80) F.LC[LC_LH + F.tid - 64] = 0u;
    __syncthreads();
    if (F.tid < 2) { unsigned o = 0; for (int e = 0; e < 8; ++e) { F.LC[LC_TOFF + F.tid * 8 + e] = o; o += (F.LC[LC_CNT + F.tid * 8 + e] + 255u) >> 8; } F.LC[LC_TOT + F.tid] = o; }
    const int rows_per = (M + F.G - 1) / F.G, r0 = F.bx * rows_per, r1 = (r0 + rows_per < M) ? r0 + rows_per : M;
    int me[2] = {0, 0}, mr[2] = {0, 0};
    for (int base = r0; base < r1; base += NTHR) {
        const int m = base + F.tid;
        if (m < r1) { me[0] = toke[2 * m]; me[1] = toke[2 * m + 1];
            mr[0] = (int)lds_inc(&F.LC[LC_LH + me[0]]); mr[1] = (int)lds_inc(&F.LC[LC_LH + 8 + me[1]]); }
    }
    __syncthreads();
    if (F.tid < 16) F.LC[LC_BASE + F.tid] = __hip_atomic_fetch_add(F.ctl + CW_MOE + 1024 + F.tid * 64, F.LC[LC_LH + F.tid], RLX_AGENT);
    __syncthreads();
    { const int m = r0 + F.tid;
      if (m < r1) {
#pragma unroll
        for (int s = 0; s < 2; ++s) { const int row = (int)F.LC[LC_TOFF + s * 8 + me[s]] * 256 + (int)F.LC[LC_BASE + s * 8 + me[s]] + mr[s];
            list[s * MOE_ROWS + row] = m; wl[s * MOE_ROWS + row] = tokw[2 * m + s]; rsl[s * MOE_ROWS + row] = rs[m]; } } }
    if (F.bx < 16) { const int se = F.bx, s = se >> 3; const int cnt = (int)F.LC[LC_CNT + se], nt = (cnt + 255) >> 8, ro = (int)F.LC[LC_TOFF + se] * 256;
        for (int r = cnt + F.tid; r < nt * 256; r += NTHR) { list[s * MOE_ROWS + ro + r] = 0; wl[s * MOE_ROWS + ro + r] = 0.f; rsl[s * MOE_ROWS + ro + r] = 0.f; } }
    __syncthreads();
}

__device__ __forceinline__ void phase_qkprep(Frame& F, bf16* proj, const float* gq, const float* gk) {
    PHASE_ENTER(F);
    const int gw = F.vcu * NWAVES + F.wave, NGW = F.G * NWAVES;
    const int d0 = (F.lane & 7) * 8;
    float gqv[8], gkv[8];
#pragma unroll
    for (int i = 0; i < 8; ++i) { gqv[i] = gq[d0 + i] * (0.125f * LOG2E); gkv[i] = gk[d0 + i]; }
    for (int m = gw; m < M; m += NGW) {
#pragma unroll
        for (int which = 0; which < 2; ++which) {
            u32x4* p = (u32x4*)(proj + (size_t)m * DIN + (which ? C_DK : C_DQ)) + F.lane;
            const u32x4 w = *p; float v[8];
#pragma unroll
            for (int q = 0; q < 4; ++q) { v[2 * q] = bflo(w[q]); v[2 * q + 1] = bfhi(w[q]); }
            float s = 0.f;
#pragma unroll
            for (int i = 0; i < 8; ++i) s += v[i] * v[i];
            s += __shfl_xor(s, 1); s += __shfl_xor(s, 2); s += __shfl_xor(s, 4);
            const float rstd = 1.f / sqrtf(s * (1.f / 64.f) + EPS);
            u32x4 o;
#pragma unroll
            for (int q = 0; q < 4; ++q) o[q] = pk2(v[2 * q] * rstd * (which ? gkv[2 * q] : gqv[2 * q]), v[2 * q + 1] * rstd * (which ? gkv[2 * q + 1] : gqv[2 * q + 1]));
            *p = o;
        }
    }
}

__device__ __forceinline__ void phase_hgrn_naive(Frame& F, const bf16* proj, const float* lbv, const float* gn, bf16* ocat) {
    PHASE_ENTER(F);
    LAS float* Fs = (LAS float*)F.lds;
    LAS float* Ks = Fs + 2048; LAS float* Qs = Ks + 2048; LAS float* Vs = Qs + 2048; LAS float* Gs = Vs + 2048;
    LAS float* O4 = Gs + 2048;
    const int j = F.tid & 127, qr = F.tid >> 7;
    for (int it = F.bx; it < NB * 4; it += F.G) {
        const int b = it >> 2, h = it & 3;
        float S[32];
#pragma unroll
        for (int i = 0; i < 32; ++i) S[i] = 0.f;
        for (int t0 = 0; t0 < SEQ; t0 += 16) {
#pragma unroll
            for (int r = 0; r < 4; ++r) { const int idx = F.tid + NTHR * r, row = idx >> 7, col = idx & 127;
                const bf16* pr = proj + (size_t)(b * SEQ + t0 + row) * DIN + h * 128 + col;
                const float z = bf2f(pr[C_HF]), lb = lbv[h * 128 + col];
                Fs[idx] = lb + (1.f - lb) * sigm(z); Ks[idx] = (1.f - lb) * sigm(-z); Qs[idx] = bf2f(pr[C_HQ]); Vs[idx] = bf2f(pr[C_HI]); Gs[idx] = bf2f(pr[C_HG]); }
            __syncthreads();
            for (int tt = 0; tt < 16; ++tt) {
                const float v = Vs[tt * 128 + j]; float acc = 0.f;
#pragma unroll
                for (int i4 = 0; i4 < 8; ++i4) { const f32x4 f4 = *(const LAS f32x4*)(Fs + tt * 128 + qr * 32 + 4 * i4), k4 = *(const LAS f32x4*)(Ks + tt * 128 + qr * 32 + 4 * i4), q4 = *(const LAS f32x4*)(Qs + tt * 128 + qr * 32 + 4 * i4);
#pragma unroll
                    for (int c = 0; c < 4; ++c) { S[4 * i4 + c] = f4[c] * S[4 * i4 + c] + k4[c] * v; acc += S[4 * i4 + c] * q4[c]; } }
                O4[(qr * 16 + tt) * 128 + j] = acc;
            }
            __syncthreads();
#pragma unroll
            for (int rr = 0; rr < 2; ++rr) { const int tt = F.wave * 2 + rr;
                float o[2]; float ss = 0.f;
#pragma unroll
                for (int c = 0; c < 2; ++c) { const int jj = F.lane + 64 * c; o[c] = O4[(0 * 16 + tt) * 128 + jj] + O4[(1 * 16 + tt) * 128 + jj] + O4[(2 * 16 + tt) * 128 + jj] + O4[(3 * 16 + tt) * 128 + jj]; ss += o[c] * o[c]; }
                const float rstd = 1.f / sqrtf(wave_sum(ss) * (1.f / 128.f) + EPS);
#pragma unroll
                for (int c = 0; c < 2; ++c) { const int jj = F.lane + 64 * c; const float g = Gs[tt * 128 + jj];
                    ocat[(size_t)(b * SEQ + t0 + tt) * D + h * 128 + jj] = (bf16)f2bf(o[c] * rstd * gn[jj] * (g * sigm(g))); } }
            __syncthreads();
        }
    }
}

__device__ __forceinline__ void phase_attn_naive(Frame& F, const bf16* proj, bf16* tmp, const float* subg, float lam, float lam_init, bf16* ocat) {
    PHASE_ENTER(F);
    const int gw = F.vcu * NWAVES + F.wave, NGW = F.G * NWAVES;
    for (int it = gw; it < NB * 4 * (SEQ / 64); it += NGW) {
        const int qb = (SEQ / 64 - 1) - it / (NB * 4), bh = it % (NB * 4), b = bh >> 2, h = bh & 3;
        const int q = qb * 64 + F.lane; const size_t tok = (size_t)b * SEQ + q;
        const float slope2 = exp2f(-2.f * (float)(h + 1)) * LOG2E;
        for (int sub = 0; sub < 4; ++sub) {
            const int c = sub >> 1, vh = sub & 1;
            float qv[64], acc[64];
            { const u32x4* qp = (const u32x4*)(proj + tok * DIN + C_DQ + h * 128 + c * 64);
#pragma unroll
              for (int i = 0; i < 8; ++i) { const u32x4 w = qp[i];
#pragma unroll
                  for (int k = 0; k < 4; ++k) { qv[8 * i + 2 * k] = bflo(w[k]); qv[8 * i + 2 * k + 1] = bfhi(w[k]); } } }
#pragma unroll
            for (int i = 0; i < 64; ++i) acc[i] = 0.f;
            float mx = -INFINITY, l = 0.f;
            const int kend = qb * 64 + 63;
            for (int kk = 0; kk <= kend; ++kk) {
                const bf16* kr = proj + ((size_t)b * SEQ + kk) * DIN;
                const u32x4* kp = (const u32x4*)(kr + C_DK + h * 128 + c * 64);
                float s = 0.f;
#pragma unroll
                for (int i = 0; i < 8; ++i) { const u32x4 w = kp[i];
#pragma unroll
                    for (int k = 0; k < 4; ++k) { s += qv[8 * i + 2 * k] * bflo(w[k]); s += qv[8 * i + 2 * k + 1] * bfhi(w[k]); } }
                if (kk <= q) {
                    const float lg = s - slope2 * (float)(q - kk);
                    const float mn = fmaxf(mx, lg), al = exp2f(mx - mn), p = exp2f(lg - mn);
                    l = l * al + p; mx = mn;
                    const u32x4* vp = (const u32x4*)(kr + C_DV + h * 128 + vh * 64);
#pragma unroll
                    for (int i = 0; i < 8; ++i) { const u32x4 w = vp[i];
#pragma unroll
                        for (int k = 0; k < 4; ++k) { acc[8 * i + 2 * k] = acc[8 * i + 2 * k] * al + p * bflo(w[k]); acc[8 * i + 2 * k + 1] = acc[8 * i + 2 * k + 1] * al + p * bfhi(w[k]); } }
                }
            }
            const float rl = 1.f / l;
            u32x4* tp = (u32x4*)(tmp + ((tok * 4 + h) * 2 + c) * 128 + vh * 64);
#pragma unroll
            for (int i = 0; i < 8; ++i) { u32x4 w;
#pragma unroll
                for (int k = 0; k < 4; ++k) w[k] = pk2(acc[8 * i + 2 * k] * rl, acc[8 * i + 2 * k + 1] * rl);
                tp[i] = w; }
        }
        VM_WAIT();
        { const u32x4* t0 = (const u32x4*)(tmp + ((tok * 4 + h) * 2 + 0) * 128); const u32x4* t1 = (const u32x4*)(tmp + ((tok * 4 + h) * 2 + 1) * 128);
          float o[128]; float ss = 0.f;
#pragma unroll
          for (int i = 0; i < 16; ++i) { const u32x4 a = t0[i], bq = t1[i];
#pragma unroll
              for (int k = 0; k < 4; ++k) { o[8 * i + 2 * k] = bflo(a[k]) - lam * bflo(bq[k]); o[8 * i + 2 * k + 1] = bfhi(a[k]) - lam * bfhi(bq[k]); ss += o[8 * i + 2 * k] * o[8 * i + 2 * k] + o[8 * i + 2 * k + 1] * o[8 * i + 2 * k + 1]; } }
          const float sc = (1.f - lam_init) / sqrtf(ss * (1.f / 128.f) + EPS);
          u32x4* op = (u32x4*)(ocat + tok * D + 512 + h * 128);
#pragma unroll
          for (int i = 0; i < 16; ++i) { u32x4 w;
#pragma unroll
              for (int k = 0; k < 4; ++k) w[k] = pk2(o[8 * i + 2 * k] * sc * subg[8 * i + 2 * k], o[8 * i + 2 * k + 1] * sc * subg[8 * i + 2 * k + 1]);
              op[i] = w; } }
    }
}


__device__ __forceinline__ void phase_attn_prep(Frame& F, bf16* proj, const float* gq, const float* gk, unsigned char* kimg, unsigned char* vimg) {
    PHASE_ENTER(F);
    const int gw = F.vcu * NWAVES + F.wave, NGW = F.G * NWAVES;
    const int d0 = (F.lane & 7) * 8;
    float gqv[8], gkv[8];
#pragma unroll
    for (int i = 0; i < 8; ++i) { gqv[i] = gq[d0 + i] * (0.125f * LOG2E); gkv[i] = gk[d0 + i]; }
    u32x4 nx[2];
    if (gw < M) { nx[0] = *((const u32x4*)(proj + (size_t)gw * DIN + C_DQ) + F.lane); nx[1] = *((const u32x4*)(proj + (size_t)gw * DIN + C_DK) + F.lane); }
    for (int m = gw; m < M; m += NGW) {
        const int b = m / SEQ, pos = m % SEQ;
        const u32x4 cur0 = nx[0], cur1 = nx[1];
        if (m + NGW < M) { nx[0] = *((const u32x4*)(proj + (size_t)(m + NGW) * DIN + C_DQ) + F.lane); nx[1] = *((const u32x4*)(proj + (size_t)(m + NGW) * DIN + C_DK) + F.lane); }
#pragma unroll
        for (int which = 0; which < 2; ++which) {
            u32x4* p = (u32x4*)(proj + (size_t)m * DIN + (which ? C_DK : C_DQ)) + F.lane;
            const u32x4 w = which ? cur1 : cur0; float v[8];
#pragma unroll
            for (int q = 0; q < 4; ++q) { v[2 * q] = bflo(w[q]); v[2 * q + 1] = bfhi(w[q]); }
            float sq = 0.f;
#pragma unroll
            for (int i = 0; i < 8; ++i) sq += v[i] * v[i];
            sq += __shfl_xor(sq, 1); sq += __shfl_xor(sq, 2); sq += __shfl_xor(sq, 4);
            const float rstd = __builtin_amdgcn_rsqf(sq * (1.f / 64.f) + EPS);
            u32x4 o;
#pragma unroll
            for (int q = 0; q < 4; ++q) o[q] = pk2(v[2 * q] * rstd * (which ? gkv[2 * q] : gqv[2 * q]), v[2 * q + 1] * rstd * (which ? gkv[2 * q + 1] : gqv[2 * q + 1]));
            if (which == 0) *p = o;
            else { const int hc = F.lane >> 3;
                const int tile = pos >> 6, kvl = pos & 63, half = kvl >> 5, ks = d0 >> 4, hb = (d0 >> 3) & 1, l = (kvl & 31) + 32 * hb;
                *(u32x4*)(kimg + ((size_t)((b * 8 + hc) * 64 + tile)) * 8192 + (half * 4 + ks) * 1024 + l * 16) = o; }
        }
    }
    LAS unsigned char* vs = F.lds + F.wave * 16384;
    for (int it = gw; it < NB * 4 * 64; it += NGW) {
        const int bh = it >> 6, tile = it & 63, b = bh >> 2, h = bh & 3;
        const bf16* src = proj + (size_t)(b * SEQ + tile * 64) * DIN + C_DV + h * 128;
#pragma unroll
        for (int i = 0; i < 16; ++i) { const int row = 4 * i + (F.lane >> 4), ch = F.lane & 15;
            *(LAS u32x4*)(vs + row * 256 + ch * 16) = *(const u32x4*)(src + (size_t)row * DIN + ch * 8); }
        LDS_WAIT(); asm volatile("" ::: "memory");
        unsigned char* dst = vimg + (size_t)it * 16384 + F.lane * 16;
        const int dl = F.lane & 31, hh = F.lane >> 5;
#pragma unroll
        for (int f = 0; f < 16; ++f) { const int db = f >> 2, t2 = (f >> 1) & 1, sp = f & 1;
            const LAS bf16* col = (const LAS bf16*)vs + (32 * t2 + 16 * sp + 4 * hh) * 128 + 32 * db + dl;
            u32x4 o;
            o.x = (unsigned)col[0 * 128] | ((unsigned)col[1 * 128] << 16); o.y = (unsigned)col[2 * 128] | ((unsigned)col[3 * 128] << 16);
            o.z = (unsigned)col[8 * 128] | ((unsigned)col[9 * 128] << 16); o.w = (unsigned)col[10 * 128] | ((unsigned)col[11 * 128] << 16);
            *(u32x4*)(dst + f * 1024) = o; }
        LDS_WAIT(); asm volatile("" ::: "memory");
    }
}

typedef float f32x16 __attribute__((ext_vector_type(16)));
__device__ __forceinline__ bf16x8 pack8(float a0, float a1, float a2, float a3, float a4, float a5, float a6, float a7) {
    u32x4 w; w.x = pg8::cvt_pk_bf16(a0, a1); w.y = pg8::cvt_pk_bf16(a2, a3); w.z = pg8::cvt_pk_bf16(a4, a5); w.w = pg8::cvt_pk_bf16(a6, a7); return __builtin_bit_cast(bf16x8, w); }
__device__ __forceinline__ void phase_attn(Frame& F, const bf16* proj, const unsigned char* kimg, const unsigned char* vimg, const float* subg, const float* misc, const int* order, gu32* ticket, bf16* ocat) {
    PHASE_ENTER(F);
    const int lane = F.lane, wave = F.wave, hi = lane >> 5, l31 = lane & 31, cm = wave >> 2, wq = wave & 3;
    constexpr int VR0 = 65536;
#define ATT_LDSRD(dst, vaddr, off) asm volatile("ds_read_b128 %0, %1 offset:%2" : "=v"(dst) : "v"(vaddr), "i"(off))
#define ATT_LDSWAIT(dst, n) asm volatile("s_waitcnt lgkmcnt(%1)" : "+v"(dst) : "i"(n))
#define ATT_DMA(src, dstoff) __builtin_amdgcn_global_load_lds((const unsigned*)(src), (LAS unsigned*)(F.lds + (dstoff)), 16, 0, 0)
#define ATT_DMA_K(t, slot) do { const size_t o_ = (size_t)(t) * 8192 + wave * 1024 + lane * 16; ATT_DMA(kb0 + o_, (slot) * 16384 + wave * 1024); ATT_DMA(kb1 + o_, (slot) * 16384 + 8192 + wave * 1024); } while (0)
#define ATT_DMA_V(t, slot) do { const size_t o_ = (size_t)(t) * 16384 + wave * 1024 + lane * 16; ATT_DMA(vb + o_, VR0 + (slot) * 16384 + wave * 1024); ATT_DMA(vb + o_ + 8192, VR0 + (slot) * 16384 + 8192 + wave * 1024); } while (0)
    const float lam = misc[0], lam_init = misc[1], B2 = misc[2];
    if (F.tid == 0) F.LC[76] = __hip_atomic_fetch_add(ticket, 1u, RLX_AGENT);
    __syncthreads();
    for (;;) {
        const int tk = (int)F.LC[76]; if (tk >= 1024) break;
        unsigned tk_next = 0u; if (F.tid == 0) tk_next = __hip_atomic_fetch_add(ticket, 1u, RLX_AGENT);
        const int v = order[tk], bh = v >> 5, qb = v & 31, b = bh >> 2, h = bh & 3;
        const int q0 = qb * 128, NT = 2 * qb + 2, qpos = q0 + 32 * wq + l31;
        int TS = (q0 - (int)misc[3 + h]) >> 6; if (TS < 0) TS = 0;
        const unsigned char* kb0 = kimg + (size_t)((bh * 2 + 0) * 64) * 8192; const unsigned char* kb1 = kimg + (size_t)((bh * 2 + 1) * 64) * 8192;
        const unsigned char* vb = vimg + (size_t)(bh * 64) * 16384;
        bf16x8 qf[4];
        { const bf16* qp = proj + (size_t)(b * SEQ + qpos) * DIN + C_DQ + h * 128 + cm * 64 + 8 * hi;
#pragma unroll
          for (int ks = 0; ks < 4; ++ks) qf[ks] = *(const bf16x8*)(qp + 16 * ks); }
        const float slope2 = exp2f(-2.f * (float)(h + 1)) * LOG2E;
        const float cb = -slope2 * (float)qpos - B2 + slope2 * (float)(4 * hi);
        f32x16 O[4];
#pragma unroll
        for (int db = 0; db < 4; ++db)
#pragma unroll
            for (int r = 0; r < 16; ++r) O[db][r] = 0.f;
        opaque_acc(O[0]); opaque_acc(O[1]); opaque_acc(O[2]); opaque_acc(O[3]);
        float lsum = 0.f;
        f32x16 pC0, pC1, pN0, pN1;
#define ATT_QK(P0, P1, t, slot) do { const float base_ = cb + slope2 * (float)(64 * (t)); \
            _Pragma("unroll") for (int r = 0; r < 16; ++r) { P0[r] = fmaf(slope2, (float)((r & 3) + 8 * (r >> 2)), base_); P1[r] = fmaf(slope2, (float)(32 + (r & 3) + 8 * (r >> 2)), base_); } \
            if ((t) >= NT - 2) { _Pragma("unroll") for (int r = 0; r < 16; ++r) { const int kv_ = 64 * (t) + (r & 3) + 8 * (r >> 2) + 4 * hi; if (kv_ > qpos) P0[r] = -INFINITY; if (kv_ + 32 > qpos) P1[r] = -INFINITY; } } \
            const unsigned ka_ = (unsigned)(uintptr_t)(F.lds + (slot) * 16384 + cm * 8192 + lane * 16); bf16x8 kq_[4]; \
            ATT_LDSRD(kq_[0], ka_, 0); ATT_LDSRD(kq_[1], ka_, 4096); ATT_LDSRD(kq_[2], ka_, 1024); ATT_LDSRD(kq_[3], ka_, 5120); \
            ATT_LDSWAIT(kq_[0], 3); P0 = __builtin_amdgcn_mfma_f32_32x32x16_bf16(kq_[0], qf[0], P0, 0, 0, 0); ATT_LDSRD(kq_[0], ka_, 2048); \
            ATT_LDSWAIT(kq_[1], 3); P1 = __builtin_amdgcn_mfma_f32_32x32x16_bf16(kq_[1], qf[0], P1, 0, 0, 0); ATT_LDSRD(kq_[1], ka_, 6144); \
            ATT_LDSWAIT(kq_[2], 3); P0 = __builtin_amdgcn_mfma_f32_32x32x16_bf16(kq_[2], qf[1], P0, 0, 0, 0); ATT_LDSRD(kq_[2], ka_, 3072); \
            ATT_LDSWAIT(kq_[3], 3); P1 = __builtin_amdgcn_mfma_f32_32x32x16_bf16(kq_[3], qf[1], P1, 0, 0, 0); ATT_LDSRD(kq_[3], ka_, 7168); \
            ATT_LDSWAIT(kq_[0], 3); P0 = __builtin_amdgcn_mfma_f32_32x32x16_bf16(kq_[0], qf[2], P0, 0, 0, 0); \
            ATT_LDSWAIT(kq_[1], 2); P1 = __builtin_amdgcn_mfma_f32_32x32x16_bf16(kq_[1], qf[2], P1, 0, 0, 0); \
            ATT_LDSWAIT(kq_[2], 1); P0 = __builtin_amdgcn_mfma_f32_32x32x16_bf16(kq_[2], qf[3], P0, 0, 0, 0); \
            ATT_LDSWAIT(kq_[3], 0); P1 = __builtin_amdgcn_mfma_f32_32x32x16_bf16(kq_[3], qf[3], P1, 0, 0, 0); } while (0)
#define ATT_CL(x) ((x) < NT ? (x) : NT - 1)
        ATT_DMA_K(TS, 0); ATT_DMA_K(ATT_CL(TS + 1), 1); ATT_DMA_V(TS, 0); ATT_DMA_K(ATT_CL(TS + 2), 2); ATT_DMA_V(ATT_CL(TS + 1), 1); ATT_DMA_K(ATT_CL(TS + 3), 3); ATT_DMA_V(ATT_CL(TS + 2), 2);
        asm volatile("s_waitcnt vmcnt(12)" ::: "memory"); __builtin_amdgcn_s_barrier(); asm volatile("" ::: "memory");
        ATT_QK(pC0, pC1, TS, 0);
        for (int t = TS; t < NT; ++t) {
            const int ks1 = (t + 1 - TS) & 3, ks0 = (t - TS) & 3, vs0 = ks0, vs3 = (t + 3 - TS) & 3;
            asm volatile("s_waitcnt vmcnt(8)" ::: "memory"); __builtin_amdgcn_s_barrier(); asm volatile("" ::: "memory");
            { ATT_DMA_K(ATT_CL(t + 4), ks0); ATT_DMA_V(ATT_CL(t + 3), vs3); }
            if (cm == 0) { if (t + 1 < NT) ATT_QK(pN0, pN1, t + 1, ks1); }
            bf16x8 pk[2][2];
            { float sa = 0.f, sb = 0.f;
#pragma unroll
              for (int r = 0; r < 16; ++r) { pC0[r] = __builtin_amdgcn_exp2f(pC0[r]); pC1[r] = __builtin_amdgcn_exp2f(pC1[r]); sa += pC0[r]; sb += pC1[r]; }
              lsum += sa + sb;
              pk[0][0] = pack8(pC0[0], pC0[1], pC0[2], pC0[3], pC0[4], pC0[5], pC0[6], pC0[7]); pk[0][1] = pack8(pC0[8], pC0[9], pC0[10], pC0[11], pC0[12], pC0[13], pC0[14], pC0[15]);
              pk[1][0] = pack8(pC1[0], pC1[1], pC1[2], pC1[3], pC1[4], pC1[5], pC1[6], pC1[7]); pk[1][1] = pack8(pC1[8], pC1[9], pC1[10], pC1[11], pC1[12], pC1[13], pC1[14], pC1[15]); }
            { const unsigned va_ = (unsigned)(uintptr_t)(F.lds + VR0 + vs0 * 16384 + lane * 16);
              bf16x8 vfr[4];
              ATT_LDSRD(vfr[0], va_, 0); ATT_LDSRD(vfr[1], va_, 1024); ATT_LDSRD(vfr[2], va_, 2048); ATT_LDSRD(vfr[3], va_, 3072);
#define ATT_PV1(i, nwait) do { ATT_LDSWAIT(vfr[(i) & 3], nwait); O[(i) >> 2] = __builtin_amdgcn_mfma_f32_32x32x16_bf16(vfr[(i) & 3], pk[((i) >> 1) & 1][(i) & 1], O[(i) >> 2], 0, 0, 0); \
                  if ((i) + 4 < 16) ATT_LDSRD(vfr[(i) & 3], va_, ((i) + 4) * 1024); } while (0)
              ATT_PV1(0, 3); ATT_PV1(1, 3); ATT_PV1(2, 3); ATT_PV1(3, 3); ATT_PV1(4, 3); ATT_PV1(5, 3); ATT_PV1(6, 3); ATT_PV1(7, 3);
              ATT_PV1(8, 3); ATT_PV1(9, 3); ATT_PV1(10, 3); ATT_PV1(11, 3); ATT_PV1(12, 3); ATT_PV1(13, 2); ATT_PV1(14, 1); ATT_PV1(15, 0);
#undef ATT_PV1
            }
            if (cm == 1) { if (t + 1 < NT) ATT_QK(pN0, pN1, t + 1, ks1); }
            pC0 = pN0; pC1 = pN1;
        }
        lsum += __shfl_xor(lsum, 32);
        const float rl = 1.f / lsum;
        asm volatile("s_waitcnt vmcnt(0) lgkmcnt(0)" ::: "memory"); __builtin_amdgcn_s_barrier(); asm volatile("" ::: "memory");
        LAS float* comb = (LAS float*)F.lds + wq * 4096 + lane;
        if (cm == 1) {
#pragma unroll
            for (int db = 0; db < 4; ++db)
#pragma unroll
                for (int r = 0; r < 16; ++r) comb[(db * 16 + r) * 64] = O[db][r] * rl;
        }
        asm volatile("s_waitcnt lgkmcnt(0)" ::: "memory"); __builtin_amdgcn_s_barrier(); asm volatile("" ::: "memory");
        if (cm == 0) {
            float ss = 0.f;
#pragma unroll
            for (int db = 0; db < 4; ++db)
#pragma unroll
                for (int r = 0; r < 16; ++r) { const float o = O[db][r] * rl - lam * comb[(db * 16 + r) * 64]; O[db][r] = o; ss += o * o; }
            ss += __shfl_xor(ss, 32);
            const float sc = (1.f - lam_init) / sqrtf(ss * (1.f / 128.f) + EPS);
            bf16* op = ocat + (size_t)(b * SEQ + qpos) * D + 512 + h * 128 + 4 * hi;
#pragma unroll
            for (int db = 0; db < 4; ++db)
#pragma unroll
                for (int g = 0; g < 4; ++g) { const f32x4 sg = *(const f32x4*)(subg + 32 * db + 8 * g + 4 * hi);
                    u32x2 w; w.x = pk2(O[db][4 * g] * sc * sg[0], O[db][4 * g + 1] * sc * sg[1]); w.y = pk2(O[db][4 * g + 2] * sc * sg[2], O[db][4 * g + 3] * sc * sg[3]);
                    *(u32x2*)(op + 32 * db + 8 * g) = w; }
        }
        if (F.tid == 0) F.LC[76] = tk_next;
        asm volatile("s_waitcnt lgkmcnt(0)" ::: "memory"); __builtin_amdgcn_s_barrier(); asm volatile("" ::: "memory");
    }
#undef ATT_DMA
#undef ATT_CL
#undef ATT_LDSRD
#undef ATT_LDSWAIT
#undef ATT_DMA_K
#undef ATT_DMA_V
#undef ATT_QK
}


template <bool FULL>
__device__ __forceinline__ void phase_hgrn(Frame& F, const bf16* proj, const float* lbv, const float* gn, float* Limg, float* Dtot, bf16* ocat) {
    PHASE_ENTER(F);
    const int lane = F.lane, wave = F.wave, hi = lane >> 5, l31 = lane & 31, jb = wave & 3, tb = wave >> 2;
    const int ip = F.tid & 63, tq = wave;
    LAS unsigned char* Qp = F.lds;
    LAS unsigned char* Kp = F.lds + 17408;
    LAS unsigned char* KT = F.lds + 34816;
    LAS unsigned char* VT = F.lds + 53248;
    LAS float* GT = (LAS float*)(F.lds + 71680);
    LAS float* D1 = (LAS float*)(F.lds + 75776);
    LAS float* D2 = D1 + 128;
    LAS unsigned char* AT = F.lds + 76800;
    LAS float* SS = (LAS float*)(F.lds + 82944);
    for (int u = F.bx; u < NB * 4 * 8; u += F.G) {
        const int bh = u >> 3, seg = u & 7, b = bh >> 2, h = bh & 3;
        if (!FULL && seg == 7) continue;
        f32x16 S[4];
#pragma unroll
        for (int ib = 0; ib < 4; ++ib)
#pragma unroll
            for (int r = 0; r < 16; ++r) S[ib][r] = 0.f;
        if (FULL) {
            for (int g = 0; g < seg; ++g) { const int up = bh * 8 + g;
#pragma unroll
                for (int ib = 0; ib < 4; ++ib) { const float* lp = Limg + (size_t)up * 16384 + ((jb * 4 + ib) * 64 + lane) * 16; const float* dp = Dtot + up * 128 + 32 * ib + 4 * hi;
#pragma unroll
                    for (int q = 0; q < 4; ++q) { const f32x4 lv = *(const f32x4*)(lp + 4 * q), dv = *(const f32x4*)(dp + 8 * q);
#pragma unroll
                        for (int c = 0; c < 4; ++c) S[ib][4 * q + c] = S[ib][4 * q + c] * dv[c] + lv[c]; } } }
        }
        float dsum0 = 0.f, dsum1 = 0.f;
        const float lb0 = lbv[h * 128 + 2 * ip], lb1 = lbv[h * 128 + 2 * ip + 1];
        unsigned zz[8], vv[8], qq[8];
#define HG_LOAD_RAW(chn) do { const bf16* pr_ = proj + ((size_t)b * SEQ + seg * 512 + (chn) * 64 + 8 * tq) * DIN + h * 128 + 2 * ip; \
            _Pragma("unroll") for (int rr = 0; rr < 8; ++rr) { zz[rr] = *(const unsigned*)(pr_ + (size_t)rr * DIN + C_HF); vv[rr] = *(const unsigned*)(pr_ + (size_t)rr * DIN + C_HI); if (FULL) qq[rr] = *(const unsigned*)(pr_ + (size_t)rr * DIN + C_HQ); } } while (0)
        HG_LOAD_RAW(0);
        for (int ch = 0; ch < 8; ++ch) {
            const size_t tok0 = (size_t)b * SEQ + seg * 512 + ch * 64;
            u32x2 gate[4];
            if (FULL) { const bf16* gp = proj + (tok0 + 32 * tb + l31) * DIN + C_HG + h * 128 + 32 * jb + 4 * hi;
#pragma unroll
                for (int g = 0; g < 4; ++g) gate[g] = *(const u32x2*)(gp + 8 * g); }
            float cs0[8], cs1[8], kk0[8], kk1[8];
            { float c0 = 0.f, c1 = 0.f;
#pragma unroll
              for (int rr = 0; rr < 8; ++rr) { const float z0 = bflo(zz[rr]), z1 = bfhi(zz[rr]);
                  const float e0 = __expf(-z0), e1 = __expf(-z1), s0 = __builtin_amdgcn_rcpf(1.f + e0), s1 = __builtin_amdgcn_rcpf(1.f + e1);
                  c0 += __builtin_amdgcn_logf(lb0 + (1.f - lb0) * s0); c1 += __builtin_amdgcn_logf(lb1 + (1.f - lb1) * s1); cs0[rr] = c0; cs1[rr] = c1;
                  kk0[rr] = (1.f - lb0) * e0 * s0; kk1[rr] = (1.f - lb1) * e1 * s1; }
              GT[tq * 128 + 2 * ip] = c0; GT[tq * 128 + 2 * ip + 1] = c1; }
            __syncthreads();
            float pre0 = 0.f, pre1 = 0.f, rho0 = 0.f, rho1 = 0.f, tot0 = 0.f, tot1 = 0.f;
#pragma unroll
            for (int g = 0; g < 8; ++g) { const f32x2 gt = *(const LAS f32x2*)(GT + g * 128 + 2 * ip);
                if (g < tq) { pre0 += gt.x; pre1 += gt.y; } if (g < 4) { rho0 += gt.x; rho1 += gt.y; } tot0 += gt.x; tot1 += gt.y; }
            { u32x4 kt0, kt1, vt0, vt1;
#pragma unroll
              for (int rr = 0; rr < 8; rr += 2) {
                  float k0[2], k1[2];
#pragma unroll
                  for (int e = 0; e < 2; ++e) { const int r2 = rr + e; const float b0 = pre0 + cs0[r2], b1 = pre1 + cs1[r2];
                      k0[e] = kk0[r2] * __builtin_amdgcn_exp2f(rho0 - b0); k1[e] = kk1[r2] * __builtin_amdgcn_exp2f(rho1 - b1);
                      *(LAS unsigned*)(Kp + (8 * tq + r2) * 272 + 4 * ip) = pk2(k0[e], k1[e]);
                      if (FULL) { const float q0 = bflo(qq[r2]) * __builtin_amdgcn_exp2f(b0 - rho0), q1 = bfhi(qq[r2]) * __builtin_amdgcn_exp2f(b1 - rho1);
                          *(LAS unsigned*)(Qp + (8 * tq + r2) * 272 + 4 * ip) = pk2(q0, q1); } }
                  kt0[rr >> 1] = pk2(k0[0], k0[1]); kt1[rr >> 1] = pk2(k1[0], k1[1]);
                  vt0[rr >> 1] = (vv[rr] & 0xffffu) | (vv[rr + 1] << 16); vt1[rr >> 1] = (vv[rr] >> 16) | (vv[rr + 1] & 0xffff0000u); }
              *(LAS u32x4*)(KT + (2 * ip) * 144 + 16 * tq) = kt0; *(LAS u32x4*)(KT + (2 * ip + 1) * 144 + 16 * tq) = kt1;
              *(LAS u32x4*)(VT + (2 * ip) * 144 + 16 * tq) = vt0; *(LAS u32x4*)(VT + (2 * ip + 1) * 144 + 16 * tq) = vt1; }
            if (tq == 0) { D1[2 * ip] = __builtin_amdgcn_exp2f(rho0); D1[2 * ip + 1] = __builtin_amdgcn_exp2f(rho1); D2[2 * ip] = __builtin_amdgcn_exp2f(tot0 - rho0); D2[2 * ip + 1] = __builtin_amdgcn_exp2f(tot1 - rho1); }
            dsum0 += tot0; dsum1 += tot1;
            __syncthreads();
            if (ch < 7) HG_LOAD_RAW(ch + 1);
#pragma unroll
            for (int ib = 0; ib < 4; ++ib)
#pragma unroll
                for (int q = 0; q < 4; ++q) { const f32x4 dv = *(const LAS f32x4*)(D1 + 32 * ib + 8 * q + 4 * hi);
#pragma unroll
                    for (int c = 0; c < 4; ++c) S[ib][4 * q + c] *= dv[c]; }
            f32x16 Ot;
            if (FULL) {
#pragma unroll
                for (int r = 0; r < 16; ++r) Ot[r] = 0.f;
                opaque_acc(Ot);
#pragma unroll
                for (int ib = 0; ib < 4; ++ib)
#pragma unroll
                    for (int sp = 0; sp < 2; ++sp) { const bf16x8 a = pack8(S[ib][8 * sp], S[ib][8 * sp + 1], S[ib][8 * sp + 2], S[ib][8 * sp + 3], S[ib][8 * sp + 4], S[ib][8 * sp + 5], S[ib][8 * sp + 6], S[ib][8 * sp + 7]);
                        const LAS unsigned char* qp = Qp + (32 * tb + l31) * 272 + (32 * ib + 16 * sp + 4 * hi) * 2;
                        const u32x2 lo = *(const LAS u32x2*)qp, hi2 = *(const LAS u32x2*)(qp + 16);
                        const u32x4 bw = {lo.x, lo.y, hi2.x, hi2.y};
                        Ot = __builtin_amdgcn_mfma_f32_32x32x16_bf16(a, __builtin_bit_cast(bf16x8, bw), Ot, 0, 0, 0); }
                for (int sb = 0; sb <= tb; ++sb) {
                    f32x16 P;
#pragma unroll
                    for (int r = 0; r < 16; ++r) P[r] = 0.f;
                    opaque_acc(P);
#pragma unroll
                    for (int ks = 0; ks < 8; ++ks) { const bf16x8 a = *(const LAS bf16x8*)(Kp + (32 * sb + l31) * 272 + (16 * ks + 8 * hi) * 2), bq = *(const LAS bf16x8*)(Qp + (32 * tb + l31) * 272 + (16 * ks + 8 * hi) * 2);
                        P = __builtin_amdgcn_mfma_f32_32x32x16_bf16(a, bq, P, 0, 0, 0); }
                    if (sb == tb) {
#pragma unroll
                        for (int r = 0; r < 16; ++r) if ((r & 3) + 8 * (r >> 2) + 4 * hi > l31) P[r] = 0.f; }
                    else asm volatile("s_nop 15" : "+v"(P));
#pragma unroll
                    for (int sp = 0; sp < 2; ++sp) { const LAS unsigned char* vp = VT + (32 * jb + l31) * 144 + (32 * sb + 16 * sp + 4 * hi) * 2;
                        const u32x2 lo = *(const LAS u32x2*)vp, hi2 = *(const LAS u32x2*)(vp + 16);
                        const u32x4 aw = {lo.x, lo.y, hi2.x, hi2.y};
                        const bf16x8 bq = pack8(P[8 * sp], P[8 * sp + 1], P[8 * sp + 2], P[8 * sp + 3], P[8 * sp + 4], P[8 * sp + 5], P[8 * sp + 6], P[8 * sp + 7]);
                        Ot = __builtin_amdgcn_mfma_f32_32x32x16_bf16(__builtin_bit_cast(bf16x8, aw), bq, Ot, 0, 0, 0); } }
            }
#pragma unroll
            for (int ks = 0; ks < 4; ++ks) { const bf16x8 bv = *(const LAS bf16x8*)(VT + (32 * jb + l31) * 144 + (16 * ks + 8 * hi) * 2);
#pragma unroll
                for (int ib = 0; ib < 4; ++ib) { const bf16x8 a = *(const LAS bf16x8*)(KT + (32 * ib + l31) * 144 + (16 * ks + 8 * hi) * 2);
                    S[ib] = __builtin_amdgcn_mfma_f32_32x32x16_bf16(a, bv, S[ib], 0, 0, 0); } }
#pragma unroll
            for (int ib = 0; ib < 4; ++ib)
#pragma unroll
                for (int q = 0; q < 4; ++q) { const f32x4 dv = *(const LAS f32x4*)(D2 + 32 * ib + 8 * q + 4 * hi);
#pragma unroll
                    for (int c = 0; c < 4; ++c) S[ib][4 * q + c] *= dv[c]; }
            if (FULL) {
                float ss = 0.f;
#pragma unroll
                for (int r = 0; r < 16; ++r) ss += Ot[r] * Ot[r];
                ss += __shfl_xor(ss, 32);
                if (hi == 0) SS[jb * 64 + 32 * tb + l31] = ss;
                __syncthreads();
                const int t = 32 * tb + l31;
                const float rstd = 1.f / sqrtf((SS[t] + SS[64 + t] + SS[128 + t] + SS[192 + t]) * (1.f / 128.f) + EPS);
                bf16* op = ocat + (tok0 + t) * D + h * 128 + 32 * jb + 4 * hi;
#pragma unroll
                for (int g = 0; g < 4; ++g) { const f32x4 gv = *(const f32x4*)(gn + 32 * jb + 8 * g + 4 * hi);
                    const float g0 = bflo(gate[g].x), g1 = bfhi(gate[g].x), g2 = bflo(gate[g].y), g3 = bfhi(gate[g].y);
                    u32x2 w; w.x = pk2(Ot[4 * g] * rstd * gv[0] * (g0 * sigm(g0)), Ot[4 * g + 1] * rstd * gv[1] * (g1 * sigm(g1)));
                    w.y = pk2(Ot[4 * g + 2] * rstd * gv[2] * (g2 * sigm(g2)), Ot[4 * g + 3] * rstd * gv[3] * (g3 * sigm(g3)));
                    *(u32x2*)(op + 8 * g) = w; }
            }
        }
        if (!FULL) {
            if (tb == 0) {
#pragma unroll
                for (int ib = 0; ib < 4; ++ib) { float* lp = Limg + (size_t)u * 16384 + ((jb * 4 + ib) * 64 + lane) * 16;
#pragma unroll
                    for (int q = 0; q < 4; ++q) *(f32x4*)(lp + 4 * q) = (f32x4){S[ib][4 * q], S[ib][4 * q + 1], S[ib][4 * q + 2], S[ib][4 * q + 3]}; } }
            if (tq == 0) { Dtot[u * 128 + 2 * ip] = __builtin_amdgcn_exp2f(dsum0); Dtot[u * 128 + 2 * ip + 1] = __builtin_amdgcn_exp2f(dsum1); }
        }
        __syncthreads();
    }
#undef HG_LOAD_RAW
}


template <bool FULL>
__device__ __forceinline__ void phase_hgrn2(Frame& F, const bf16* proj, const float* lbv, const float* gn, float* Limg, float* Dtot, bf16* ocat) {
    PHASE_ENTER(F);
    const int lane = F.lane, wave = F.wave, hi = lane >> 5, l31 = lane & 31;
    constexpr int SETB = 72704, KPO = 17408, KTO = 34816, VTO = 53248, D1O = 71680, D2O = 72192, SSO = 2 * SETB;
    constexpr int NI = FULL ? 10 : 9;
    for (int u = F.bx; u < NB * 4 * 8; u += F.G) {
        const int bh = u >> 3, seg = u & 7, b = bh >> 2, h = bh & 3;
        if (!FULL && seg == 7) continue;
        const size_t tokS = (size_t)b * SEQ + seg * 512;
        if (wave >= 4) {
            const int pw = wave - 4, cg = lane & 15, rg = lane >> 4, col = 32 * pw + 2 * cg;
            const float lb0 = lbv[h * 128 + col], lb1 = lbv[h * 128 + col + 1];
            float dsum0 = 0.f, dsum1 = 0.f;
            unsigned zz[16], vv[16], qq[16];
#define HG2_LOAD_RAW(chn) do { const bf16* pr_ = proj + (tokS + (chn) * 64 + 16 * rg) * DIN + h * 128 + col; \
            _Pragma("unroll") for (int rr = 0; rr < 16; ++rr) { zz[rr] = *(const unsigned*)(pr_ + (size_t)rr * DIN + C_HF); vv[rr] = *(const unsigned*)(pr_ + (size_t)rr * DIN + C_HI); if (FULL) qq[rr] = *(const unsigned*)(pr_ + (size_t)rr * DIN + C_HQ); } } while (0)
            HG2_LOAD_RAW(0);
            for (int it = 0; it < NI; ++it) {
                if (it < 8) {
                    LAS unsigned char* sb_ = F.lds + (it & 1) * SETB;
                    float cs0[16], cs1[16], kk0[16], kk1[16]; unsigned vc[16], qc[16];
                    float c0 = 0.f, c1 = 0.f;
#pragma unroll
                    for (int rr = 0; rr < 16; ++rr) { const float z0 = bflo(zz[rr]), z1 = bfhi(zz[rr]);
                        const float e0 = __builtin_amdgcn_exp2f(-LOG2E * z0), e1 = __builtin_amdgcn_exp2f(-LOG2E * z1), s0 = __builtin_amdgcn_rcpf(1.f + e0), s1 = __builtin_amdgcn_rcpf(1.f + e1);
                        c0 += __builtin_amdgcn_logf(lb0 + (1.f - lb0) * s0); c1 += __builtin_amdgcn_logf(lb1 + (1.f - lb1) * s1); cs0[rr] = c0; cs1[rr] = c1;
                        kk0[rr] = (1.f - lb0) * e0 * s0; kk1[rr] = (1.f - lb1) * e1 * s1; vc[rr] = vv[rr]; if (FULL) qc[rr] = qq[rr]; }
                    if (it < 7) HG2_LOAD_RAW(it + 1);
                    float pre0 = 0.f, pre1 = 0.f, rho0 = 0.f, rho1 = 0.f, tot0 = 0.f, tot1 = 0.f;
#pragma unroll
                    for (int g = 0; g < 4; ++g) { const float t0 = __shfl(c0, cg + 16 * g), t1 = __shfl(c1, cg + 16 * g);
                        if (g < rg) { pre0 += t0; pre1 += t1; } if (g < 2) { rho0 += t0; rho1 += t1; } tot0 += t0; tot1 += t1; }
                    u32x4 kt0[2], kt1[2], vt0[2], vt1[2];
#pragma unroll
                    for (int rr = 0; rr < 16; rr += 2) { float k0[2], k1[2];
#pragma unroll
                        for (int e = 0; e < 2; ++e) { const int r2 = rr + e; const float b0 = pre0 + cs0[r2], b1 = pre1 + cs1[r2];
                            k0[e] = kk0[r2] * __builtin_amdgcn_exp2f(rho0 - b0); k1[e] = kk1[r2] * __builtin_amdgcn_exp2f(rho1 - b1);
                            *(LAS unsigned*)(sb_ + KPO + (16 * rg + r2) * 272 + 2 * col) = pk2(k0[e], k1[e]);
                            if (FULL) { const float q0 = bflo(qc[r2]) * __builtin_amdgcn_exp2f(b0 - rho0), q1 = bfhi(qc[r2]) * __builtin_amdgcn_exp2f(b1 - rho1);
                                *(LAS unsigned*)(sb_ + (16 * rg + r2) * 272 + 2 * col) = pk2(q0, q1); } }
                        kt0[rr >> 3][(rr >> 1) & 3] = pk2(k0[0], k0[1]); kt1[rr >> 3][(rr >> 1) & 3] = pk2(k1[0], k1[1]);
                        vt0[rr >> 3][(rr >> 1) & 3] = (vc[rr] & 0xffffu) | (vc[rr + 1] << 16); vt1[rr >> 3][(rr >> 1) & 3] = (vc[rr] >> 16) | (vc[rr + 1] & 0xffff0000u); }
#pragma unroll
                    for (int p = 0; p < 2; ++p) {
                        *(LAS u32x4*)(sb_ + KTO + col * 144 + 32 * rg + 16 * p) = kt0[p]; *(LAS u32x4*)(sb_ + KTO + (col + 1) * 144 + 32 * rg + 16 * p) = kt1[p];
                        *(LAS u32x4*)(sb_ + VTO + col * 144 + 32 * rg + 16 * p) = vt0[p]; *(LAS u32x4*)(sb_ + VTO + (col + 1) * 144 + 32 * rg + 16 * p) = vt1[p]; }
                    if (rg == 0) { *(LAS f32x2*)(sb_ + D1O + 4 * col) = (f32x2){__builtin_amdgcn_exp2f(rho0), __builtin_amdgcn_exp2f(rho1)};
                        *(LAS f32x2*)(sb_ + D2O + 4 * col) = (f32x2){__builtin_amdgcn_exp2f(tot0 - rho0), __builtin_amdgcn_exp2f(tot1 - rho1)}; }
                    dsum0 += tot0; dsum1 += tot1;
                }
                __syncthreads();
            }
            if (!FULL) { if (rg == 0) { Dtot[u * 128 + col] = __builtin_amdgcn_exp2f(dsum0); Dtot[u * 128 + col + 1] = __builtin_amdgcn_exp2f(dsum1); } }
#undef HG2_LOAD_RAW
        } else {
            const int jb = wave;
            f32x16 S[4];
#pragma unroll
            for (int ib = 0; ib < 4; ++ib)
#pragma unroll
                for (int r = 0; r < 16; ++r) S[ib][r] = 0.f;
            if (FULL) {
                for (int g = 0; g < seg; ++g) { const int up = bh * 8 + g;
#pragma unroll
                    for (int ib = 0; ib < 4; ++ib) { const float* lp = Limg + (size_t)up * 16384 + ((jb * 4 + ib) * 64 + lane) * 16; const float* dp = Dtot + up * 128 + 32 * ib + 4 * hi;
#pragma unroll
                        for (int q = 0; q < 4; ++q) { const f32x4 lv = *(const f32x4*)(lp + 4 * q), dv = *(const f32x4*)(dp + 8 * q);
#pragma unroll
                            for (int c = 0; c < 4; ++c) S[ib][4 * q + c] = S[ib][4 * q + c] * dv[c] + lv[c]; } } }
            }
            f32x16 OtP[2]; u32x2 gateP[2][4];
#pragma unroll
            for (int tb = 0; tb < 2; ++tb) {
#pragma unroll
                for (int r = 0; r < 16; ++r) OtP[tb][r] = 0.f;
#pragma unroll
                for (int g = 0; g < 4; ++g) gateP[tb][g] = (u32x2){0u, 0u}; }
            for (int it = 0; it < NI; ++it) {
                if (FULL && it >= 2) {
                    const LAS float* SSb = (const LAS float*)(F.lds + SSO) + ((it - 2) & 1) * 256; const size_t tok0 = tokS + (size_t)(it - 2) * 64;
#pragma unroll
                    for (int tb = 0; tb < 2; ++tb) { const int t = 32 * tb + l31;
                        const float rstd = __builtin_amdgcn_rsqf((SSb[t] + SSb[64 + t] + SSb[128 + t] + SSb[192 + t]) * (1.f / 128.f) + EPS);
                        bf16* op = ocat + (tok0 + t) * D + h * 128 + 32 * jb + 4 * hi;
#pragma unroll
                        for (int g = 0; g < 4; ++g) { const f32x4 gv = *(const f32x4*)(gn + 32 * jb + 8 * g + 4 * hi);
                            const float g0 = bflo(gateP[tb][g].x), g1 = bfhi(gateP[tb][g].x), g2 = bflo(gateP[tb][g].y), g3 = bfhi(gateP[tb][g].y);
                            u32x2 w; w.x = pk2(OtP[tb][4 * g] * rstd * gv[0] * (g0 * sigm(g0)), OtP[tb][4 * g + 1] * rstd * gv[1] * (g1 * sigm(g1)));
                            w.y = pk2(OtP[tb][4 * g + 2] * rstd * gv[2] * (g2 * sigm(g2)), OtP[tb][4 * g + 3] * rstd * gv[3] * (g3 * sigm(g3)));
                            *(u32x2*)(op + 8 * g) = w; } }
                }
                if (it >= 1 && it <= 8) {
                    const int ch = it - 1; const size_t tok0 = tokS + (size_t)ch * 64;
                    const LAS unsigned char* Qp = F.lds + (ch & 1) * SETB; const LAS unsigned char* Kp = Qp + KPO; const LAS unsigned char* KT = Qp + KTO; const LAS unsigned char* VT = Qp + VTO;
                    const LAS float* D1 = (const LAS float*)(Qp + D1O); const LAS float* D2 = (const LAS float*)(Qp + D2O);
                    u32x2 gateN[2][4];
                    if (FULL) {
#pragma unroll
                        for (int tb = 0; tb < 2; ++tb) { const bf16* gp = proj + (tok0 + 32 * tb + l31) * DIN + C_HG + h * 128 + 32 * jb + 4 * hi;
#pragma unroll
                            for (int g = 0; g < 4; ++g) gateN[tb][g] = *(const u32x2*)(gp + 8 * g); } }
#pragma unroll
                    for (int ib = 0; ib < 4; ++ib)
#pragma unroll
                        for (int q = 0; q < 4; ++q) { const f32x4 dv = *(const LAS f32x4*)(D1 + 32 * ib + 8 * q + 4 * hi);
#pragma unroll
                            for (int c = 0; c < 4; ++c) S[ib][4 * q + c] *= dv[c]; }
                    f32x16 Ot[2];
                    if (FULL) {
#pragma unroll
                        for (int tb = 0; tb < 2; ++tb)
#pragma unroll
                            for (int r = 0; r < 16; ++r) Ot[tb][r] = 0.f;
                        opaque_acc(Ot[0]); opaque_acc(Ot[1]);
#pragma unroll
                        for (int ib = 0; ib < 4; ++ib)
#pragma unroll
                            for (int sp = 0; sp < 2; ++sp) { const bf16x8 a = pack8(S[ib][8 * sp], S[ib][8 * sp + 1], S[ib][8 * sp + 2], S[ib][8 * sp + 3], S[ib][8 * sp + 4], S[ib][8 * sp + 5], S[ib][8 * sp + 6], S[ib][8 * sp + 7]);
#pragma unroll
                                for (int tb = 0; tb < 2; ++tb) { const LAS unsigned char* qp = Qp + (32 * tb + l31) * 272 + (32 * ib + 16 * sp + 4 * hi) * 2;
                                    const u32x2 lo = *(const LAS u32x2*)qp, hi2 = *(const LAS u32x2*)(qp + 16);
                                    const u32x4 bw = {lo.x, lo.y, hi2.x, hi2.y};
                                    Ot[tb] = __builtin_amdgcn_mfma_f32_32x32x16_bf16(a, __builtin_bit_cast(bf16x8, bw), Ot[tb], 0, 0, 0); } }
#pragma unroll
                        for (int tile = 0; tile < 3; ++tile) { const int sb = tile >> 1, tb = (tile + 1) >> 1;
                            f32x16 P;
#pragma unroll
                            for (int r = 0; r < 16; ++r) P[r] = 0.f;
                            opaque_acc(P);
#pragma unroll
                            for (int ks = 0; ks < 8; ++ks) { const bf16x8 a = *(const LAS bf16x8*)(Kp + (32 * sb + l31) * 272 + (16 * ks + 8 * hi) * 2), bq = *(const LAS bf16x8*)(Qp + (32 * tb + l31) * 272 + (16 * ks + 8 * hi) * 2);
                                P = __builtin_amdgcn_mfma_f32_32x32x16_bf16(a, bq, P, 0, 0, 0); }
                            if (sb == tb) {
#pragma unroll
                                for (int r = 0; r < 16; ++r) if ((r & 3) + 8 * (r >> 2) + 4 * hi > l31) P[r] = 0.f; }
                            else asm volatile("s_nop 15" : "+v"(P));
#pragma unroll
                            for (int sp = 0; sp < 2; ++sp) { const LAS unsigned char* vp = VT + (32 * jb + l31) * 144 + (32 * sb + 16 * sp + 4 * hi) * 2;
                                const u32x2 lo = *(const LAS u32x2*)vp, hi2 = *(const LAS u32x2*)(vp + 16);
                                const u32x4 aw = {lo.x, lo.y, hi2.x, hi2.y};
                                const bf16x8 bq = pack8(P[8 * sp], P[8 * sp + 1], P[8 * sp + 2], P[8 * sp + 3], P[8 * sp + 4], P[8 * sp + 5], P[8 * sp + 6], P[8 * sp + 7]);
                                Ot[tb] = __builtin_amdgcn_mfma_f32_32x32x16_bf16(__builtin_bit_cast(bf16x8, aw), bq, Ot[tb], 0, 0, 0); } }
                    }
#pragma unroll
                    for (int ks = 0; ks < 4; ++ks) { const bf16x8 bv = *(const LAS bf16x8*)(VT + (32 * jb + l31) * 144 + (16 * ks + 8 * hi) * 2);
#pragma unroll
                        for (int ib = 0; ib < 4; ++ib) { const bf16x8 a = *(const LAS bf16x8*)(KT + (32 * ib + l31) * 144 + (16 * ks + 8 * hi) * 2);
                            S[ib] = __builtin_amdgcn_mfma_f32_32x32x16_bf16(a, bv, S[ib], 0, 0, 0); } }
#pragma unroll
                    for (int ib = 0; ib < 4; ++ib)
#pragma unroll
                        for (int q = 0; q < 4; ++q) { const f32x4 dv = *(const LAS f32x4*)(D2 + 32 * ib + 8 * q + 4 * hi);
#pragma unroll
                            for (int c = 0; c < 4; ++c) S[ib][4 * q + c] *= dv[c]; }
                    if (FULL) {
                        LAS float* SSb = (LAS float*)(F.lds + SSO) + (ch & 1) * 256;
#pragma unroll
                        for (int tb = 0; tb < 2; ++tb) { float ss = 0.f;
#pragma unroll
                            for (int r = 0; r < 16; ++r) ss += Ot[tb][r] * Ot[tb][r];
                            ss += __shfl_xor(ss, 32);
                            if (hi == 0) SSb[jb * 64 + 32 * tb + l31] = ss;
                            OtP[tb] = Ot[tb];
#pragma unroll
                            for (int g = 0; g < 4; ++g) gateP[tb][g] = gateN[tb][g]; }
                    }
                }
                __syncthreads();
            }
            if (!FULL) {
#pragma unroll
                for (int ib = 0; ib < 4; ++ib) { float* lp = Limg + (size_t)u * 16384 + ((jb * 4 + ib) * 64 + lane) * 16;
#pragma unroll
                    for (int q = 0; q < 4; ++q) *(f32x4*)(lp + 4 * q) = (f32x4){S[ib][4 * q], S[ib][4 * q + 1], S[ib][4 * q + 2], S[ib][4 * q + 3]}; }
            }
        }
        __syncthreads();
    }
}

#ifndef REP_ATTN
#define REP_ATTN 1
#endif
#ifndef REP_HGRN
#define REP_HGRN 1
#endif
#ifndef REP_G1
#define REP_G1 1
#endif
#ifndef REP_MUP
#define REP_MUP 1
#endif
#ifndef REP_F1
#define REP_F1 1
#endif
#ifndef REP_PREP
#define REP_PREP 1
#endif
__global__ void __launch_bounds__(NTHR, 2) mega_fwd(Args args) {
    extern __shared__ __attribute__((aligned(16))) unsigned char lds[];
    Frame F;
    F.lds = (LAS unsigned char*)lds;
    F.LC = (volatile LAS unsigned*)(F.lds + LDSCTL_OFF);
    volatile LAS unsigned* MISC = (volatile LAS unsigned*)(F.lds + MISC_OFF);
    F.tid = threadIdx.x; F.lane = F.tid & 63; F.wave = __builtin_amdgcn_readfirstlane(F.tid >> 6);
    F.G = gridDim.x; { const int bx = blockIdx.x; F.vcu = (F.G % 8 == 0) ? (bx % 8) * (F.G / 8) + bx / 8 : bx; }
    F.ws = args.ws; F.ctl = (gu32*)(args.ws + WS_CTL); F.adaf = (float*)(args.ws + WS_ADA);
    for (int u = F.tid; u < (LDS_BYTES - LDSCTL_OFF) / 4; u += NTHR) ((LAS unsigned*)(F.lds + LDSCTL_OFF))[u] = 0u;
    __syncthreads();
    XcdBarrier bar = xcd_barrier_post((unsigned*)(F.ctl + CW_BAR), MISC + 8);
#define GRID_BAR() xcd_barrier(bar)
    unsigned char* ws = args.ws;
    F.bx = blockIdx.x;
    bf16* Hb = (bf16*)(ws + WS_H); bf16* OC = (bf16*)(ws + WS_OCAT); bf16* PROJ = (bf16*)(ws + WS_PROJ);
    float* xout = args.out; bf16* X16 = (bf16*)(ws + WS_X16);

    phase_prologue(F, args, 0);
    GRID_BAR();

    for (int l = 0; l < DEPTH; ++l) {
        const float* ada_l = F.adaf + AO_ADA + (size_t)l * NB * ADA_N;
        if (l == 0) phase_norm<false, 1, false>(F, args.in[0], args.in[4] + l * D, ada_l, 0, 1, ws + WS_H8, nullptr, F.adaf + AO_RS, nullptr, nullptr, nullptr);
        else phase_norm<false, 1, true>(F, X16, args.in[4] + l * D, ada_l, 0, 1, ws + WS_H8, nullptr, F.adaf + AO_RS, nullptr, nullptr, nullptr);
        GRID_BAR();
        { pg8::Gemm g{(const bf16*)(ws + WS_H8), (const bf16*)(ws + WS_WIN8 + (size_t)l * DIN * D), D / 2}; pg8::StaticOrder S; S.init(M, DIN, F.G, (int)blockIdx.x);
          pg8::EpiBf16<true> E{PROJ, DIN, QW_INV, F.adaf + AO_RS, C_GA / 256}; pg8::ADense AO;
          if (l == 0 && (blockIdx.x & 1)) { phase_prologue(F, args, 1); __syncthreads(); }
          for (int rep = 0; rep < REP_G1; ++rep) pg8::gemm_phase<pg8::EpiBf16<true>, pg8::StaticOrder, pg8::ADense, true, 2>(F.lds, g, S, AO, E);
          if (l == 0 && !(blockIdx.x & 1)) { __syncthreads(); phase_prologue(F, args, 1); } }
        GRID_BAR();
#ifdef NAIVE_ATTN
        phase_qkprep(F, PROJ, args.in[9] + l * 64, args.in[10] + l * 64);
#else
        phase_attn_prep(F, PROJ, args.in[9] + l * 64, args.in[10] + l * 64, ws + WS_KIMG, ws + WS_VIMG);
#endif
#ifndef NAIVE_HGRN
        __syncthreads();
        phase_hgrn2<false>(F, PROJ, F.adaf + AO_LB + l * 512, args.in[8] + l * 128, (float*)(ws + WS_HL), (float*)(ws + WS_HD), OC);
#endif
        GRID_BAR();
#ifdef NAIVE_HGRN
        phase_hgrn_naive(F, PROJ, F.adaf + AO_LB + l * 512, args.in[8] + l * 128, OC);
#else
        for (int rep = 0; rep < REP_HGRN; ++rep) phase_hgrn2<true>(F, PROJ, F.adaf + AO_LB + l * 512, args.in[8] + l * 128, (float*)(ws + WS_HL), (float*)(ws + WS_HD), OC);
#endif
#ifdef NAIVE_ATTN
        phase_attn_naive(F, PROJ, Hb, args.in[12] + l * 128, F.adaf[AO_MISC + l * 8 + 0], F.adaf[AO_MISC + l * 8 + 1], OC);
#else
        phase_attn(F, PROJ, ws + WS_KIMG, ws + WS_VIMG, args.in[12] + l * 128, F.adaf + AO_MISC + l * 8, (const int*)(F.adaf + AO_ORD) + l * 1024, F.ctl + CW_ATT + 64 * l, OC);
#endif
        GRID_BAR();
        { pg8::Gemm g{OC, (const bf16*)(ws + WS_WPAB) + (size_t)l * D * D, D}; pg8::StaticOrder S; S.init(M, D, F.G, (int)blockIdx.x);
          pg8::EpiMerge E{PROJ, Hb}; pg8::ADense AO;
          pg8::gemm_phase<pg8::EpiMerge, pg8::StaticOrder, pg8::ADense, true>(F.lds, g, S, AO, E); }
        GRID_BAR();
        { pg8::Gemm g{Hb, (const bf16*)(ws + WS_WO) + (size_t)l * D * D, D}; pg8::StaticOrder S; S.init(M, D, F.G, (int)blockIdx.x);
          pg8::ADense AO;
          if (l == 0) { pg8::EpiRes<true> E{args.in[0], X16, ada_l + 2 * D, 1.f}; pg8::gemm_phase<pg8::EpiRes<true>, pg8::StaticOrder, pg8::ADense, true>(F.lds, g, S, AO, E); }
          else {
              if (blockIdx.x & 1) { phase_moe_weights(F, args); __syncthreads(); }
              pg8::EpiRes<false> E{X16, X16, ada_l + 2 * D, 1.f}; pg8::gemm_phase<pg8::EpiRes<false>, pg8::StaticOrder, pg8::ADense, true>(F.lds, g, S, AO, E);
              if (!(blockIdx.x & 1)) { __syncthreads(); phase_moe_weights(F, args); } } }
        GRID_BAR();
        if (l == 0) {
            phase_norm<false, 1, true>(F, X16, args.in[5] + l * D, ada_l, 3, 4, Hb, nullptr, F.adaf + AO_RS, nullptr, nullptr, nullptr);
            GRID_BAR();
            { pg8::Gemm g{Hb, (const bf16*)(ws + WS_W13), D / 2}; pg8::StaticOrder S; S.init(M, 2 * DFF, F.G, (int)blockIdx.x);
              pg8::EpiSwiglu<false, true> E{(void*)(ws + WS_HID), DFF, 0, QW_INV, F.adaf + AO_RS, nullptr}; pg8::ADense AO;
              for (int rep = 0; rep < REP_F1; ++rep) pg8::gemm_phase<pg8::EpiSwiglu<false, true>, pg8::StaticOrder, pg8::ADense, true, 2>(F.lds, g, S, AO, E); }
            GRID_BAR();
            { pg8::Gemm g{(const bf16*)(ws + WS_HID), (const bf16*)(ws + WS_W2), DFF}; pg8::StaticOrder S; S.init(M, D, F.G, (int)blockIdx.x);
              pg8::EpiRes<false> E{X16, X16, ada_l + 5 * D, 1.f}; pg8::ADense AO;
              pg8::gemm_phase<pg8::EpiRes<false>, pg8::StaticOrder, pg8::ADense, true, 0>(F.lds, g, S, AO, E); }
            GRID_BAR();
        } else {
            int* toke = (int*)(ws + WS_TOKE); float* tokw = (float*)(ws + WS_TOKW); int* list = (int*)(ws + WS_LIST); float* wl = (float*)(ws + WS_WL);
#ifndef SKIP_NORMMOE
            phase_norm<true, 1, true>(F, X16, args.in[5] + l * D, ada_l, 3, 4, Hb, nullptr, F.adaf + AO_RS, args.in[19], toke, tokw);
#endif
            GRID_BAR();
            phase_moe_sort(F, toke, tokw, list, wl, F.adaf + AO_RS, (float*)(ws + WS_RSL));
            GRID_BAR();
            constexpr int UPD = 72, SKIPR = 6;
            const int T1 = (int)F.LC[LC_TOT + 1], hv0 = ((int)F.LC[LC_TOT] * (D / 256)) % F.G, hv1 = (T1 - 128) * (D / 256);
            const pg8::Gemm gup{Hb, (const bf16*)(ws + WS_MW13), D / 2}, gdn{(const bf16*)(ws + WS_HIDM), (const bf16*)(ws + WS_MW2), DFFE / 2};
            for (int ph = 0; ph < 4; ++ph) {
              for (int part = 0; part < 2; ++part) {
                const bool dn_now = (ph == 3) ? (part == 0) : (part == (int)(blockIdx.x & 1));
                if (ph == 1 && dn_now) { pg8::MoeOrder S{F.LC, 0, D / 256, F.G, (int)blockIdx.x}; pg8::ADense AO;
                    pg8::EpiMoeDown<false> E{X16, xout, ada_l + 5 * D, list, wl, W8_INV}; pg8::gemm_phase<pg8::EpiMoeDown<false>, pg8::MoeOrder, pg8::ADense, true, 1>(F.lds, gdn, S, AO, E); }
                if (ph >= 2 && dn_now) { pg8::MoeOrder S{F.LC, 1, D / 256, F.G, (int)blockIdx.x, 0, 0, ph == 2 ? 128 : 0, ph == 2 ? 1 << 20 : 128}; pg8::ADense AO;
                    pg8::EpiMoeDown<true> E{X16, xout, ada_l + 5 * D, list, wl, W8_INV}; pg8::gemm_phase<pg8::EpiMoeDown<true>, pg8::MoeOrder, pg8::ADense, true, 1>(F.lds, gdn, S, AO, E); }
                if (ph < 3 && part == 0) { pg8::MoeOrder S{F.LC, ph == 0 ? 0 : 1, 2 * DFFE / 256, F.G, (int)blockIdx.x, ph == 0 ? 0 : (ph == 1 ? hv0 : hv1), SKIPR, ph == 1 ? UPD : 0, ph == 2 ? UPD : 1 << 20};
                  pg8::EpiSwiglu<true, true> E{(void*)(ws + WS_HIDM), DFFE, 2 * DFFE / 256, QW_INV, (const float*)(ws + WS_RSL), nullptr}; pg8::AGather AO{list};
                  for (int rep = 0; rep < REP_MUP; ++rep) pg8::gemm_phase<pg8::EpiSwiglu<true, true>, pg8::MoeOrder, pg8::AGather, true, 2>(F.lds, gup, S, AO, E); }
              }
              if (ph < 3) GRID_BAR();
            }
        }
    }
}

extern "C" void kernel_launch(void* const* d_in, const int* in_sizes, int n_in, void* d_out, int out_size, void* d_ws, size_t ws_size, hipStream_t stream) {
    static int grid = 0;
    if (grid == 0) {
        if (n_in != 23 || out_size != M * D || ws_size < WS_END) { fprintf(stderr, "kernel_launch: unexpected problem (n_in %d, out %d, ws %zu)\n", n_in, out_size, ws_size); grid = -1; return; }
        int dev = 0, cus = 0;
        if (hipGetDevice(&dev) != hipSuccess || hipDeviceGetAttribute(&cus, hipDeviceAttributeMultiprocessorCount, dev) != hipSuccess) { grid = -1; return; }
        if (hipFuncSetAttribute((const void*)mega_fwd, hipFuncAttributeMaxDynamicSharedMemorySize, LDS_BYTES) != hipSuccess) { fprintf(stderr, "kernel_launch: hipFuncSetAttribute failed\n"); grid = -1; return; }
        int per_cu = 0;
        if (hipOccupancyMaxActiveBlocksPerMultiprocessor(&per_cu, (const void*)mega_fwd, NTHR, LDS_BYTES) != hipSuccess || per_cu < 1) fprintf(stderr, "kernel_launch: occupancy query says %d\n", per_cu);
        (void)hipGetLastError();
        grid = cus;
    }
    if (grid < 0) return;
    if (hipMemsetAsync((char*)d_ws + WS_CTL, 0, CTL_ZERO_BYTES, stream) != hipSuccess) return;
    Args a{};
    for (int i = 0; i < 23; ++i) a.in[i] = (const float*)d_in[i];
    a.out = (float*)d_out; a.ws = (unsigned char*)d_ws;
    hipLaunchKernelGGL(mega_fwd, dim3(grid), dim3(NTHR), LDS_BYTES, stream, a);
}
```
